# Optimizing an MI355X kernel written in HIP

```python
import math
import jax, jax.numpy as jnp
from jax import lax
import numpy as np

D_MODEL = 2048
BATCH = 1
SEQ = 8192
DEPTH = 4

GRID_W = 64
CTX_LEN = 256
HEAD_DIM = 128
BLOCK = 128
ROPE_THETA = 10000.0
EPS = 1e-6
NEG_INF = -1e30

A_HEADS = 8
A_KV_HEADS = 2
A_GROUP = A_HEADS // A_KV_HEADS
WINDOW = 128
A_WIDTH = A_HEADS * HEAD_DIM
A_KV = A_KV_HEADS * HEAD_DIM

B_WIDTH = 1024
HYENA_ORDER = 2
HYENA_BANDS = 16
HYENA_EMB = 1 + 2 * HYENA_BANDS
HYENA_HID = 64
SHORT_CONV = 3
DECAY_TARGET = 1e-2
DECAY_MAX = abs(math.log(DECAY_TARGET)) / 0.3
DECAY_MIN = abs(math.log(DECAY_TARGET)) / 1.5

C_HEADS = 8
C_KV_HEADS = 2
C_GROUP = C_HEADS // C_KV_HEADS
C_WIDTH = C_HEADS * HEAD_DIM
C_KV = C_KV_HEADS * HEAD_DIM

M_HEADS = 8
Q_LORA = 512
KV_LORA = 256
NOPE_DIM = 128
ROPE_DIM = 64
V_DIM = 128
QK_DIM = NOPE_DIM + ROPE_DIM
M_WIDTH = M_HEADS * V_DIM

BRANCH = A_WIDTH + B_WIDTH
EVEN_SPLIT = (A_WIDTH, A_KV, A_KV, 3 * B_WIDTH, BRANCH)
ODD_SPLIT = (C_WIDTH, C_KV, C_KV, Q_LORA, KV_LORA, ROPE_DIM, BRANCH)
EVEN_IN = sum(EVEN_SPLIT)
ODD_IN = sum(ODD_SPLIT)
N_EVEN = (DEPTH + 1) // 2
N_ODD = DEPTH // 2

kernel_name = 'hybrid_prefix_diffusion_backbone'

F32 = jnp.float32


def _rmsnorm(x, g):
    xf = x.astype(F32)
    y = xf * lax.rsqrt(jnp.mean(xf * xf, axis=-1, keepdims=True) + EPS)
    return (y * g.astype(F32)).astype(x.dtype)


def _split(p, sizes):
    idx = np.cumsum(sizes)[:-1].tolist()
    return jnp.split(p, idx, axis=-1)


def _heads(t, n):
    return t.reshape(t.shape[:-1] + (n, t.shape[-1] // n))


def _axial_rope_tables(n_tokens, n_rot):
    rows = n_tokens // GRID_W
    row = jnp.broadcast_to(jnp.arange(rows)[:, None], (rows, GRID_W)).reshape(-1).astype(F32)
    col = jnp.broadcast_to(jnp.arange(GRID_W)[None, :], (rows, GRID_W)).reshape(-1).astype(F32)
    n_freq = n_rot // 4
    inv = ROPE_THETA ** (-jnp.arange(n_freq, dtype=F32) / n_freq)
    ang = jnp.concatenate([row[:, None] * inv, col[:, None] * inv], axis=-1)
    return jnp.cos(ang), jnp.sin(ang)


def _rope(x, cos, sin):
    half = x.shape[-1] // 2
    x1, x2 = x[..., :half], x[..., half:]
    cs = cos[None, :, None, :].astype(x.dtype)
    sn = sin[None, :, None, :].astype(x.dtype)
    return jnp.concatenate([x1 * cs - x2 * sn, x2 * cs + x1 * sn], axis=-1)


def _attend(q, k, v, sink=None):
    s = jnp.einsum('bqhgd,bkhd->bhgqk', q, k, preferred_element_type=F32) * (q.shape[-1] ** -0.5)
    if sink is not None:
        sk = jnp.broadcast_to(sink.astype(F32)[None, :, :, None, None], s.shape[:-1] + (1,))
        p = jax.nn.softmax(jnp.concatenate([s, sk], axis=-1), axis=-1)[..., :-1]
    else:
        p = jax.nn.softmax(s, axis=-1)
    return jnp.einsum('bhgqk,bkhd->bqhgd', p.astype(v.dtype), v)


def _block_sweep(q, k, v):
    B, S, Hk, G, dk = q.shape
    nb = S // BLOCK
    qb = jnp.moveaxis(q.reshape(B, nb, BLOCK, Hk, G, dk), 1, 0)
    o = lax.map(lambda qi: _attend(qi, k, v), qb)
    return jnp.moveaxis(o, 0, 1).reshape(B, S, -1)


def _window_attention(q, k, v, kc, vc, sink):
    B, S, Hk, G, d = q.shape
    nb = S // BLOCK
    qb = q.reshape(B, nb, BLOCK, Hk, G, d)

    def windows(t):
        tp = jnp.pad(t, ((0, 0), (BLOCK, BLOCK), (0, 0), (0, 0))).reshape(B, nb + 2, BLOCK, Hk, t.shape[-1])
        return jnp.concatenate([tp[:, :-2], tp[:, 1:-1], tp[:, 2:]], axis=2)

    kw, vw = windows(k), windows(v)
    scale = d ** -0.5
    s_w = jnp.einsum('bnqhgd,bnkhd->bnhgqk', qb, kw, preferred_element_type=F32) * scale
    s_c = jnp.einsum('bnqhgd,bkhd->bnhgqk', qb, kc, preferred_element_type=F32) * scale
    qpos = jnp.arange(nb)[:, None] * BLOCK + jnp.arange(BLOCK)[None, :]
    kpos = (jnp.arange(nb)[:, None] - 1) * BLOCK + jnp.arange(3 * BLOCK)[None, :]
    valid = ((jnp.abs(qpos[:, :, None] - kpos[:, None, :]) <= WINDOW)
             & ((kpos >= 0) & (kpos < S))[:, None, :])
    s_w = jnp.where(valid[None, :, None, None], s_w, NEG_INF)
    sk = jnp.broadcast_to(sink.astype(F32)[None, None, :, :, None, None], s_w.shape[:-1] + (1,))
    p = jax.nn.softmax(jnp.concatenate([s_w, s_c, sk], axis=-1), axis=-1)
    nw, nc = 3 * BLOCK, kc.shape[1]
    o = (jnp.einsum('bnhgqk,bnkhd->bnqhgd', p[..., :nw].astype(v.dtype), vw)
         + jnp.einsum('bnhgqk,bkhd->bnqhgd', p[..., nw:nw + nc].astype(vc.dtype), vc))
    return o.reshape(B, S, Hk * G * d)


def _conv3(u, w, b):
    up = jnp.pad(u, ((0, 0), (1, 1), (0, 0)))
    return up[:, :-2] * w[0] + up[:, 1:-1] * w[1] + up[:, 2:] * w[2] + b


def _hyena_filters(L, w1, b1, f1, w2, b2, f2, w3):
    pos = jnp.arange(L, dtype=F32)
    t = pos / max(L - 1, 1)
    bands = jnp.linspace(1e-4, HYENA_BANDS - 1, HYENA_BANDS, dtype=F32)
    ang = (2.0 * math.pi / L) * pos[:, None] * bands[None, :]
    z = jnp.concatenate([t[:, None], jnp.cos(ang), -jnp.sin(ang)], axis=-1)
    h = jnp.sin(f1.astype(F32) * (z @ w1.astype(F32) + b1.astype(F32)))
    h = jnp.sin(f2.astype(F32) * (h @ w2.astype(F32) + b2.astype(F32)))
    h = (h @ w3.astype(F32)).reshape(L, HYENA_ORDER, 2, B_WIDTH)
    deltas = jnp.linspace(DECAY_MAX, DECAY_MIN, B_WIDTH, dtype=F32)
    return h * jnp.exp(-t[:, None] * deltas[None, :])[:, None, None, :]


def _long_conv(u, h):
    L = u.shape[1]
    k = jnp.concatenate([h[:, 0], jnp.zeros_like(h[:1, 0]), h[:0:-1, 1]], axis=0)
    k = k / jnp.sum(jnp.abs(k), axis=0, keepdims=True)
    uf = jnp.fft.rfft(u.astype(F32), n=2 * L, axis=1)
    kf = jnp.fft.rfft(k, n=2 * L, axis=0)
    y = jnp.fft.irfft(uf * kf[None], n=2 * L, axis=1)[:, :L]
    return y.astype(u.dtype)


def _hyena(p, conv_w, conv_b, filt, bias):
    u = _conv3(p, conv_w, conv_b)
    x1, x2, z = jnp.split(u, 3, axis=-1)
    z = x1 * (_long_conv(z, filt[:, 0]) + bias[0] * z)
    return x2 * (_long_conv(z, filt[:, 1]) + bias[1] * z)


def _even_mixer(u_lat, u_ctx, w_in, qn_g, kn_g, sink, conv_w, conv_b, fparams, hy_bias, rope_h, need_ctx):
    B, S, _ = u_lat.shape
    C = u_ctx.shape[1]
    q, k, v, hy, gate = _split(u_lat @ w_in, EVEN_SPLIT)
    qc, kc, vc, hyc, gatec = _split(u_ctx @ w_in, EVEN_SPLIT)
    sink_g = sink.reshape(A_KV_HEADS, A_GROUP)
    kc = _rmsnorm(_heads(kc, A_KV_HEADS), kn_g)
    vc = _heads(vc, A_KV_HEADS)
    q = _rope(_rmsnorm(_heads(q, A_HEADS), qn_g), *rope_h).reshape(B, S, A_KV_HEADS, A_GROUP, HEAD_DIM)
    k = _rope(_rmsnorm(_heads(k, A_KV_HEADS), kn_g), *rope_h)
    a = _window_attention(q, k, _heads(v, A_KV_HEADS), kc, vc, sink_g)
    b = _hyena(hy, conv_w, conv_b, _hyena_filters(S, *fparams), hy_bias)
    o_lat = jnp.concatenate([a, b], axis=-1) * jax.nn.silu(gate)
    if not need_ctx:
        return o_lat, None
    qc = _rmsnorm(_heads(qc, A_HEADS), qn_g).reshape(B, C, A_KV_HEADS, A_GROUP, HEAD_DIM)
    ac = _attend(qc, kc, vc, sink_g).reshape(B, C, A_WIDTH)
    bc = _hyena(hyc, conv_w, conv_b, _hyena_filters(C, *fparams), hy_bias)
    o_ctx = jnp.concatenate([ac, bc], axis=-1) * jax.nn.silu(gatec)
    return o_lat, o_ctx


def _mla_q(mq, cq_g, wuq, mq_g, rope):
    B, L, _ = mq.shape
    q = (_rmsnorm(mq, cq_g) @ wuq).reshape(B, L, M_HEADS, QK_DIM)
    q_n = _rmsnorm(q[..., :NOPE_DIM], mq_g[:NOPE_DIM])
    q_r = _rmsnorm(q[..., NOPE_DIM:], mq_g[NOPE_DIM:])
    if rope is not None:
        q_r = _rope(q_r, *rope)
    return jnp.concatenate([q_n, q_r], axis=-1)[:, :, :, None, :]


def _mla_kv(mkv, mkr, ckv_g, wukv, mk_g, rope):
    B, L, _ = mkv.shape
    kv = (_rmsnorm(mkv, ckv_g) @ wukv).reshape(B, L, M_HEADS, NOPE_DIM + V_DIM)
    k_n = _rmsnorm(kv[..., :NOPE_DIM], mk_g[:NOPE_DIM])
    k_r = _rmsnorm(mkr, mk_g[NOPE_DIM:])[:, :, None, :]
    if rope is not None:
        k_r = _rope(k_r, *rope)
    k = jnp.concatenate([k_n, jnp.broadcast_to(k_r, (B, L, M_HEADS, ROPE_DIM))], axis=-1)
    return k, kv[..., NOPE_DIM:]


def _odd_mixer(u_lat, u_ctx, w_in, qn_g, kn_g, cq_g, ckv_g, wuq, wukv, mq_g, mk_g, rope_h, rope_r, need_ctx):
    B, S, _ = u_lat.shape
    C = u_ctx.shape[1]
    q, k, v, mq, mkv, mkr, gate = _split(u_lat @ w_in, ODD_SPLIT)
    qc, kc, vc, mqc, mkvc, mkrc, gatec = _split(u_ctx @ w_in, ODD_SPLIT)
    kc = _rmsnorm(_heads(kc, C_KV_HEADS), kn_g)
    vc = _heads(vc, C_KV_HEADS)
    q = _rope(_rmsnorm(_heads(q, C_HEADS), qn_g), *rope_h).reshape(B, S, C_KV_HEADS, C_GROUP, HEAD_DIM)
    k = _rope(_rmsnorm(_heads(k, C_KV_HEADS), kn_g), *rope_h)
    o_c = _block_sweep(q, jnp.concatenate([kc, k], axis=1), jnp.concatenate([vc, _heads(v, C_KV_HEADS)], axis=1))
    km_c, vm_c = _mla_kv(mkvc, mkrc, ckv_g, wukv, mk_g, None)
    km, vm = _mla_kv(mkv, mkr, ckv_g, wukv, mk_g, rope_r)
    qm = _mla_q(mq, cq_g, wuq, mq_g, rope_r)
    o_d = _block_sweep(qm, jnp.concatenate([km_c, km], axis=1), jnp.concatenate([vm_c, vm], axis=1))
    o_lat = jnp.concatenate([o_c, o_d], axis=-1) * jax.nn.silu(gate)
    if not need_ctx:
        return o_lat, None
    qc = _rmsnorm(_heads(qc, C_HEADS), qn_g).reshape(B, C, C_KV_HEADS, C_GROUP, HEAD_DIM)
    oc_c = _attend(qc, kc, vc).reshape(B, C, C_WIDTH)
    od_c = _attend(_mla_q(mqc, cq_g, wuq, mq_g, None), km_c, vm_c).reshape(B, C, M_WIDTH)
    o_ctx = jnp.concatenate([oc_c, od_c], axis=-1) * jax.nn.silu(gatec)
    return o_lat, o_ctx


def setup_inputs(seed: int = 0) -> dict:
    key = jax.random.key(seed)
    ks = iter(jax.random.split(key, 40))

    def nrm(shape, scale):
        return jax.random.normal(next(ks), shape, F32) * scale

    D = D_MODEL
    return {
        'x': nrm((BATCH, SEQ, D), 1.0),
        'c': nrm((BATCH, D), 1.0),
        'ctx': nrm((BATCH, CTX_LEN, D), 1.0),
        'c_ctx': nrm((D,), 1.0),
        'ada_w': nrm((DEPTH, D, 3 * D), 0.5 * D ** -0.5),
        'ada_b': nrm((DEPTH, 3 * D), 0.01),
        'norm_g': 1.0 + nrm((DEPTH, D), 0.02),
        'w_out': nrm((DEPTH, BRANCH, D), BRANCH ** -0.5),
        'ev_w_in': nrm((N_EVEN, D, EVEN_IN), D ** -0.5),
        'ev_qn_g': 1.0 + nrm((N_EVEN, HEAD_DIM), 0.02),
        'ev_kn_g': 1.0 + nrm((N_EVEN, HEAD_DIM), 0.02),
        'ev_sink': nrm((N_EVEN, A_HEADS), 0.5),
        'ev_conv_w': nrm((N_EVEN, SHORT_CONV, 3 * B_WIDTH), SHORT_CONV ** -0.5),
        'ev_conv_b': nrm((N_EVEN, 3 * B_WIDTH), 0.01),
        'hy_w1': nrm((N_EVEN, HYENA_EMB, HYENA_HID), HYENA_EMB ** -0.5),
        'hy_b1': nrm((N_EVEN, HYENA_HID), 0.1),
        'hy_f1': 1.0 + nrm((N_EVEN, HYENA_HID), 0.1),
        'hy_w2': nrm((N_EVEN, HYENA_HID, HYENA_HID), HYENA_HID ** -0.5),
        'hy_b2': nrm((N_EVEN, HYENA_HID), 0.1),
        'hy_f2': 1.0 + nrm((N_EVEN, HYENA_HID), 0.1),
        'hy_w3': nrm((N_EVEN, HYENA_HID, HYENA_ORDER * 2 * B_WIDTH), HYENA_HID ** -0.5),
        'hy_bias': nrm((N_EVEN, HYENA_ORDER, B_WIDTH), 1.0),
        'od_w_in': nrm((N_ODD, D, ODD_IN), D ** -0.5),
        'od_qn_g': 1.0 + nrm((N_ODD, HEAD_DIM), 0.02),
        'od_kn_g': 1.0 + nrm((N_ODD, HEAD_DIM), 0.02),
        'od_cq_g': 1.0 + nrm((N_ODD, Q_LORA), 0.02),
        'od_ckv_g': 1.0 + nrm((N_ODD, KV_LORA), 0.02),
        'od_wuq': nrm((N_ODD, Q_LORA, M_HEADS * QK_DIM), Q_LORA ** -0.5),
        'od_wukv': nrm((N_ODD, KV_LORA, M_HEADS * (NOPE_DIM + V_DIM)), KV_LORA ** -0.5),
        'od_mq_g': 1.0 + nrm((N_ODD, QK_DIM), 0.02),
        'od_mk_g': 1.0 + nrm((N_ODD, QK_DIM), 0.02),
    }


def reference(x, c, ctx, c_ctx, ada_w, ada_b, norm_g, w_out,
              ev_w_in, ev_qn_g, ev_kn_g, ev_sink, ev_conv_w, ev_conv_b,
              hy_w1, hy_b1, hy_f1, hy_w2, hy_b2, hy_f2, hy_w3, hy_bias,
              od_w_in, od_qn_g, od_kn_g, od_cq_g, od_ckv_g, od_wuq, od_wukv, od_mq_g, od_mk_g):
    S = x.shape[1]
    rope_h = _axial_rope_tables(S, HEAD_DIM)
    rope_r = _axial_rope_tables(S, ROPE_DIM)
    h_lat, h_ctx = x, ctx
    for i in range(DEPTH):
        need_ctx = i < DEPTH - 1
        sh_l, sc_l, g_l = jnp.split((jax.nn.silu(c) @ ada_w[i] + ada_b[i])[:, None, :], 3, axis=-1)
        sh_c, sc_c, g_c = jnp.split(jax.nn.silu(c_ctx) @ ada_w[i] + ada_b[i], 3, axis=-1)
        u_lat = _rmsnorm(h_lat, norm_g[i]) * (1.0 + sc_l) + sh_l
        u_ctx = _rmsnorm(h_ctx, norm_g[i]) * (1.0 + sc_c) + sh_c
        if i % 2 == 0:
            e = i // 2
            o_lat, o_ctx = _even_mixer(
                u_lat, u_ctx, ev_w_in[e], ev_qn_g[e], ev_kn_g[e], ev_sink[e], ev_conv_w[e], ev_conv_b[e],
                (hy_w1[e], hy_b1[e], hy_f1[e], hy_w2[e], hy_b2[e], hy_f2[e], hy_w3[e]), hy_bias[e],
                rope_h, need_ctx)
        else:
            o = i // 2
            o_lat, o_ctx = _odd_mixer(
                u_lat, u_ctx, od_w_in[o], od_qn_g[o], od_kn_g[o], od_cq_g[o], od_ckv_g[o],
                od_wuq[o], od_wukv[o], od_mq_g[o], od_mk_g[o], rope_h, rope_r, need_ctx)
        h_lat = h_lat + g_l * (o_lat @ w_out[i])
        if need_ctx:
            h_ctx = h_ctx + g_c * (o_ctx @ w_out[i])
    return h_lat
```

```cpp
#include <hip/hip_runtime.h>
#include <hip/hip_cooperative_groups.h>
#include <cstdio>
namespace cg = cooperative_groups;

#define DI __device__ __forceinline__
#ifndef PROBE
#define PROBE 0
#endif
typedef unsigned short bf16_t;
using bf16x8 = __attribute__((ext_vector_type(8))) short;
using s16x4 = __attribute__((ext_vector_type(4))) short;
using f32x16 = __attribute__((ext_vector_type(16))) float;
using f32x4 = __attribute__((ext_vector_type(4))) float;
using u32x4 = __attribute__((ext_vector_type(4))) unsigned;
using u32x2 = __attribute__((ext_vector_type(2))) unsigned;

constexpr int D = 2048, SEQ = 8192, CTX = 256, MR = SEQ + CTX;
constexpr int NPE = 6656, NPO = 4608, NVO = 4416;
constexpr int FN = 16384;
constexpr int XCD_BAR_WORDS_C = 3456;
constexpr int NTH = 512;
constexpr float EPS = 1e-6f;
constexpr float LOG2E = 1.4426950408889634f;
constexpr float QSCALE128 = 0.08838834764831845f * LOG2E, QSCALE192 = 0.07216878364870322f * LOG2E;
constexpr float DECAY_MAX = 15.350567286626973f, DECAY_MIN = 3.0701134573253945f;

constexpr size_t AL(size_t x) { return (x + 255) & ~(size_t)255; }
constexpr size_t WS_WTIN_E = 0;
constexpr size_t WS_WTIN_O = WS_WTIN_E + AL((size_t)2 * NPE * D * 2);
constexpr size_t WS_WTOUT = WS_WTIN_O + AL((size_t)2 * NPO * D * 2);
constexpr size_t WS_WTUQ = WS_WTOUT + AL((size_t)4 * D * D * 2);
constexpr size_t WS_WTUKV = WS_WTUQ + AL((size_t)2 * 1536 * 512 * 2);
constexpr size_t WS_MODS = WS_WTUKV + AL((size_t)2 * 2048 * 256 * 2);
constexpr size_t WS_BAR = WS_MODS + AL((size_t)4 * 2 * 6144 * 4);
constexpr size_t WS_ROWSQ = WS_BAR + AL((size_t)XCD_BAR_WORDS_C * 4);
constexpr size_t WS_TW = WS_ROWSQ + AL((size_t)2 * 2 * MR * 4);
constexpr size_t WS_ROPE = WS_TW + AL((size_t)FN * 8);
constexpr size_t WS_ROPE64 = WS_ROPE + AL((size_t)2 * SEQ * 64 * 4);
constexpr size_t WS_HID = WS_ROPE64 + AL((size_t)2 * SEQ * 32 * 4);
constexpr size_t WS_HID256 = WS_HID + AL((size_t)2 * SEQ * 64 * 4);
constexpr size_t WS_H = WS_HID256 + AL((size_t)2 * CTX * 64 * 4);
constexpr size_t WS_U = WS_H + AL((size_t)MR * D * 4);
constexpr size_t WS_P = WS_U + AL((size_t)MR * D * 2);
constexpr size_t WS_VT = WS_P + AL((size_t)MR * NPE * 2);
constexpr size_t WS_O = WS_VT + AL((size_t)2 * 128 * MR * 2);
constexpr size_t WS_TAPS = WS_O + AL((size_t)MR * D * 2);
constexpr size_t WS_TAPS256 = WS_TAPS + AL((size_t)2 * 1024 * FN * 4);
constexpr size_t WS_YT = WS_TAPS256 + AL((size_t)2 * 1024 * 512 * 4);
constexpr size_t WS_XT = WS_YT + AL((size_t)1024 * SEQ * 4);
constexpr size_t WS_QM = WS_XT;
constexpr size_t WS_KV = WS_QM + AL((size_t)MR * 1536 * 2);
constexpr size_t WS_VMT = WS_KV + AL((size_t)MR * 2048 * 2);
constexpr size_t WS_END_ODD = WS_VMT + AL((size_t)8 * 128 * MR * 2);
constexpr size_t WS_END_EVEN = WS_XT + AL((size_t)3072 * SEQ * 4);
constexpr size_t WS_KZ = WS_END_ODD > WS_END_EVEN ? WS_END_ODD : WS_END_EVEN;
constexpr size_t WS_PART = WS_KZ;
constexpr size_t WS_END = WS_KZ + (size_t)256 * FN * 8;

constexpr int LDS_MAIN = 139264, LDS_WT = LDS_MAIN, LDS_RED = LDS_WT + 8960, LDS_BYTES = LDS_RED + 256;

struct Params { const float* in[31]; float* out; unsigned char* ws; };

typedef __attribute__((ext_vector_type(2))) __bf16 bf16x2_t;
typedef __attribute__((ext_vector_type(2))) float f32x2;
DI bf16_t f2bf(float x) { return __builtin_bit_cast(unsigned short, (__bf16)x); }
DI float bf2f(bf16_t h) { return __uint_as_float(((unsigned)h) << 16); }
DI unsigned pk2(float a, float b) { return __builtin_bit_cast(unsigned, __builtin_convertvector((f32x2){a, b}, bf16x2_t)); }
DI int TIDX() { int t = threadIdx.x; asm volatile("" : "+v"(t)); return t; }
#define XB_TMO      128
#define XB_XCNT(j)  (256  + 64 * (j))
#define XB_XSUB(j)  (1280 + 64 * (j))
#define XB_XGEN(j)  (2304 + 64 * (j))
#define XB_TOP      3328
#define XB_TOPGEN   3392
#define XB_SPIN_CAP (1u << 18)
DI unsigned xb_ld(unsigned* p) { return __hip_atomic_load(p, __ATOMIC_RELAXED, __HIP_MEMORY_SCOPE_AGENT); }
DI unsigned xb_add(unsigned* p, unsigned v) { return __hip_atomic_fetch_add(p, v, __ATOMIC_RELAXED, __HIP_MEMORY_SCOPE_AGENT); }
DI unsigned xb_xcc_id() { return (unsigned)__builtin_amdgcn_s_getreg((3 << 11) | 20) & 0xFu; }
#define XB_SPIN(cond, bar) do { unsigned _sp = 0; while (cond) { __builtin_amdgcn_s_sleep(1); \
    if ((++_sp & 255u) == 0u) { if (xb_ld(&(bar)[XB_TMO])) break; if (_sp > XB_SPIN_CAP) { atomicAdd(&(bar)[XB_TMO], 1u); break; } } } } while (0)
DI void xcd_barrier_complete(unsigned* bar, unsigned x, unsigned& nloc, unsigned& nx) {
  const unsigned G = gridDim.x;
  unsigned sum, cnt, mine, sp = 0u;
  for (;;) {
    sum = 0u; cnt = 0u; mine = 0u;
#pragma unroll
    for (unsigned j = 0; j < 16; ++j) { const unsigned c = xb_ld(&bar[XB_XCNT(j)]); sum += c; cnt += (c > 0u) ? 1u : 0u; mine = (j == x) ? c : mine; }
    if (sum == G) break;
    __builtin_amdgcn_s_sleep(1);
    if ((++sp & 255u) == 0u) { if (xb_ld(&bar[XB_TMO])) break; if (sp > XB_SPIN_CAP) { atomicAdd(&bar[XB_TMO], 1u); break; } }
  }
  nloc = mine > 0u ? mine : 1u; nx = cnt > 0u ? cnt : 1u;
}
DI void grid_barrier(unsigned* bar, volatile unsigned* st, int tid) {
  asm volatile("s_waitcnt vmcnt(0)" ::: "memory");
  __syncthreads();
  if (tid == 0) {
    __builtin_amdgcn_s_waitcnt(0);
    const unsigned x = xb_xcc_id();
    unsigned nloc = st[0], nx = st[1];
    if (nloc == 0u) { xcd_barrier_complete(bar, x, nloc, nx); st[0] = nloc; st[1] = nx; }
    const unsigned old = xb_add(&bar[XB_XSUB(x)], 1u);
    const unsigned gen = old / nloc;
    if (old + 1u == (gen + 1u) * nloc) {
      __builtin_amdgcn_fence(__ATOMIC_RELEASE, "agent");
      asm volatile("s_waitcnt vmcnt(0)" ::: "memory");
      const unsigned og = xb_add(&bar[XB_TOP], 1u);
      const unsigned tg = og / nx;
      if (og + 1u == (tg + 1u) * nx) xb_add(&bar[XB_TOPGEN], 1u);
      else XB_SPIN(xb_ld(&bar[XB_TOPGEN]) == tg, bar);
      __builtin_amdgcn_fence(__ATOMIC_ACQUIRE, "agent");
      xb_add(&bar[XB_XGEN(x)], 1u);
      asm volatile("s_waitcnt vmcnt(0)" ::: "memory");
    } else {
      XB_SPIN(xb_ld(&bar[XB_XGEN(x)]) == gen, bar);
      __builtin_amdgcn_fence(__ATOMIC_ACQUIRE, "agent");
      asm volatile("s_waitcnt vmcnt(0)" ::: "memory");
    }
  }
  __syncthreads();
}
DI int vblock() { const int b = blockIdx.x, G = gridDim.x; return (G % 8 == 0) ? (b % 8) * (G / 8) + b / 8 : b; }
DI float wave_sum(float v) {
#pragma unroll
  for (int o = 32; o > 0; o >>= 1) v += __shfl_xor(v, o);
  return v;
}
DI float silu_f(float x) { return x / (1.f + expf(-x)); }
DI int crow(int reg, int h) { return (reg & 3) + 8 * (reg >> 2) + 4 * h; }
#define MFMA16(a, b, c) __builtin_amdgcn_mfma_f32_32x32x16_bf16((a), (b), (c), 0, 0, 0)

struct c32 { float x, y; };
DI c32 cmul(c32 a, c32 b) { c32 r; r.x = a.x * b.x - a.y * b.y; r.y = a.x * b.y + a.y * b.x; return r; }
DI c32 cmulc(c32 a, c32 b) { c32 r; r.x = a.x * b.x + a.y * b.y; r.y = a.y * b.x - a.x * b.y; return r; }

DI int PADI(int p) { return p + (p >> 4); }
DI void fwd4(c32& a, c32& b, c32& c, c32& d, c32 w1, c32 w2, c32 w3, bool tw) {
  c32 t0 = {a.x + c.x, a.y + c.y}, t1 = {a.x - c.x, a.y - c.y};
  c32 t2 = {b.x + d.x, b.y + d.y};
  c32 bd = {b.x - d.x, b.y - d.y};
  c32 t3 = {bd.y, -bd.x};
  c32 y0 = {t0.x + t2.x, t0.y + t2.y};
  c32 y1 = {t1.x + t3.x, t1.y + t3.y};
  c32 y2 = {t0.x - t2.x, t0.y - t2.y};
  c32 y3 = {t1.x - t3.x, t1.y - t3.y};
  if (tw) { y1 = cmul(y1, w1); y2 = cmul(y2, w2); y3 = cmul(y3, w3); }
  a = y0; b = y1; c = y2; d = y3;
}
DI void inv4(c32& a, c32& b, c32& c, c32& d, c32 w1, c32 w2, c32 w3, bool tw) {
  if (tw) { b = cmulc(b, w1); c = cmulc(c, w2); d = cmulc(d, w3); }
  c32 t0 = {a.x + c.x, a.y + c.y}, t1 = {a.x - c.x, a.y - c.y};
  c32 t2 = {b.x + d.x, b.y + d.y};
  c32 bd = {b.x - d.x, b.y - d.y};
  c32 t3 = {-bd.y, bd.x};
  a = {t0.x + t2.x, t0.y + t2.y};
  b = {t1.x + t3.x, t1.y + t3.y};
  c = {t0.x - t2.x, t0.y - t2.y};
  d = {t1.x - t3.x, t1.y - t3.y};
}
DI c32 r16_cb(int b) {
  return b == 0 ? c32{1.f, 0.f} : b == 1 ? c32{0.9238795325112867f, -0.3826834323650898f} : b == 2 ? c32{0.7071067811865476f, -0.7071067811865476f} : c32{0.3826834323650898f, -0.9238795325112867f};
}
template <int S>
DI void fft_fwd_r16(c32* X, const c32* WT, int idx) {
  constexpr int lsp2 = 12 - 2 * (S + 1), sp2 = 1 << lsp2, sp1 = 4 * sp2;
  const int jp = idx & (sp2 - 1), base = ((idx >> lsp2) << (lsp2 + 4)) + jp;
  c32* Xb = X + PADI(base);
  c32 e[4][4];
#pragma unroll
  for (int a = 0; a < 4; ++a)
#pragma unroll
    for (int b = 0; b < 4; ++b) e[a][b] = Xb[a * (sp1 + sp1 / 16) + b * (sp2 + sp2 / 16)];
  const c32 W0 = WT[jp];
#pragma unroll
  for (int b = 0; b < 4; ++b) {
    const c32 w1 = b == 0 ? W0 : cmul(W0, r16_cb(b)), w2 = cmul(w1, w1), w3 = cmul(w2, w1);
    fwd4(e[0][b], e[1][b], e[2][b], e[3][b], w1, w2, w3, true);
  }
  {
    const c32 q2 = cmul(W0, W0), v1 = cmul(q2, q2), v2 = cmul(v1, v1), v3 = cmul(v2, v1);
#pragma unroll
    for (int a = 0; a < 4; ++a) fwd4(e[a][0], e[a][1], e[a][2], e[a][3], v1, v2, v3, true);
  }
#pragma unroll
  for (int a = 0; a < 4; ++a)
#pragma unroll
    for (int b = 0; b < 4; ++b) Xb[a * (sp1 + sp1 / 16) + b * (sp2 + sp2 / 16)] = e[a][b];
}
template <int S>
DI void fft_inv_r16(c32* X, const c32* WT, int idx) {
  constexpr int lsp2 = 12 - 2 * (S + 1), sp2 = 1 << lsp2, sp1 = 4 * sp2;
  const int jp = idx & (sp2 - 1), base = ((idx >> lsp2) << (lsp2 + 4)) + jp;
  c32* Xb = X + PADI(base);
  c32 e[4][4];
#pragma unroll
  for (int a = 0; a < 4; ++a)
#pragma unroll
    for (int b = 0; b < 4; ++b) e[a][b] = Xb[a * (sp1 + sp1 / 16) + b * (sp2 + sp2 / 16)];
  const c32 W0 = WT[jp];
  {
    const c32 q2 = cmul(W0, W0), v1 = cmul(q2, q2), v2 = cmul(v1, v1), v3 = cmul(v2, v1);
#pragma unroll
    for (int a = 0; a < 4; ++a) inv4(e[a][0], e[a][1], e[a][2], e[a][3], v1, v2, v3, true);
  }
#pragma unroll
  for (int b = 0; b < 4; ++b) {
    const c32 w1 = b == 0 ? W0 : cmul(W0, r16_cb(b)), w2 = cmul(w1, w1), w3 = cmul(w2, w1);
    inv4(e[0][b], e[1][b], e[2][b], e[3][b], w1, w2, w3, true);
  }
#pragma unroll
  for (int a = 0; a < 4; ++a)
#pragma unroll
    for (int b = 0; b < 4; ++b) Xb[a * (sp1 + sp1 / 16) + b * (sp2 + sp2 / 16)] = e[a][b];
}
DI void fft_fwd_last(c32* X, int idx) {
  const int p = 4 * idx, q = PADI(p);
  c32 a = X[q], b = X[q + 1], c = X[q + 2], d = X[q + 3];
  fwd4(a, b, c, d, a, a, a, false);
  X[q] = a; X[q + 1] = b; X[q + 2] = c; X[q + 3] = d;
}
DI void fft_inv_last(c32* X, int idx) {
  const int p = 4 * idx, q = PADI(p);
  c32 a = X[q], b = X[q + 1], c = X[q + 2], d = X[q + 3];
  inv4(a, b, c, d, a, a, a, false);
  X[q] = a; X[q + 1] = b; X[q + 2] = c; X[q + 3] = d;
}

DI void fft_fwd(c32* X, const c32* TW, int tid) {
  asm volatile("" : "+v"(tid));
  _Pragma("unroll 1") for (int r = 0; r < 2; ++r) fft_fwd_r16<0>(X, TW, tid + NTH * r);
  __syncthreads();
  asm volatile("" : "+v"(tid));
  _Pragma("unroll 1") for (int r = 0; r < 2; ++r) fft_fwd_r16<2>(X, TW + 1024, tid + NTH * r);
  __syncthreads();
  asm volatile("" : "+v"(tid));
  _Pragma("unroll 1") for (int r = 0; r < 2; ++r) fft_fwd_r16<4>(X, TW + 1088, tid + NTH * r);
  __syncthreads();
asm volatile("" : "+v"(tid));
#pragma unroll 4
  for (int b = 0; b < 8; ++b) fft_fwd_last(X, tid + NTH * b);
  __syncthreads();
}
DI void fft_fwd3(c32* X, const c32* TW, int tid) {
  asm volatile("" : "+v"(tid));
  _Pragma("unroll 1") for (int r = 0; r < 2; ++r) fft_fwd_r16<0>(X, TW, tid + NTH * r);
  __syncthreads();
  asm volatile("" : "+v"(tid));
  _Pragma("unroll 1") for (int r = 0; r < 2; ++r) fft_fwd_r16<2>(X, TW + 1024, tid + NTH * r);
  __syncthreads();
  asm volatile("" : "+v"(tid));
  _Pragma("unroll 1") for (int r = 0; r < 2; ++r) fft_fwd_r16<4>(X, TW + 1088, tid + NTH * r);
  __syncthreads();
}
DI void fft_inv3(c32* X, const c32* TW, int tid) {
  asm volatile("" : "+v"(tid));
  _Pragma("unroll 1") for (int r = 0; r < 2; ++r) fft_inv_r16<4>(X, TW + 1088, tid + NTH * r);
  __syncthreads();
  asm volatile("" : "+v"(tid));
  _Pragma("unroll 1") for (int r = 0; r < 2; ++r) fft_inv_r16<2>(X, TW + 1024, tid + NTH * r);
  __syncthreads();
  asm volatile("" : "+v"(tid));
  _Pragma("unroll 1") for (int r = 0; r < 2; ++r) fft_inv_r16<0>(X, TW, tid + NTH * r);
  __syncthreads();
}
DI int rev6(int x) { const unsigned r = __brev((unsigned)x) >> 20; return (int)(((r & 0xAAAu) >> 1) | ((r & 0x555u) << 1)); }
DI void pairprod(c32& a, c32& b, float inv) {
  const c32 K = {0.5f * (a.x + b.x), 0.5f * (a.y - b.y)};
  const c32 U = {0.5f * (a.y + b.y), -0.5f * (a.x - b.x)};
  c32 Y = cmul(K, U); Y.x *= inv; Y.y *= inv;
  a = Y; b = {Y.x, -Y.y};
}
DI void fft_inv(c32* X, const c32* TW, int tid) {
asm volatile("" : "+v"(tid));
#pragma unroll 4
  for (int b = 0; b < 8; ++b) fft_inv_last(X, tid + NTH * b);
  __syncthreads();
  asm volatile("" : "+v"(tid));
  _Pragma("unroll 1") for (int r = 0; r < 2; ++r) fft_inv_r16<4>(X, TW + 1088, tid + NTH * r);
  __syncthreads();
  asm volatile("" : "+v"(tid));
  _Pragma("unroll 1") for (int r = 0; r < 2; ++r) fft_inv_r16<2>(X, TW + 1024, tid + NTH * r);
  __syncthreads();
  asm volatile("" : "+v"(tid));
  _Pragma("unroll 1") for (int r = 0; r < 2; ++r) fft_inv_r16<0>(X, TW, tid + NTH * r);
  __syncthreads();
}

DI int perm_uq(int n) { const int hd = n / 192, d = n % 192; return d < 128 ? hd * 128 + d : 1024 + hd * 64 + (d - 128); }
DI void transpose_tile(float* tl, const float* __restrict__ src, bf16_t* __restrict__ dst, int K, int N, int t, int lane, const float* ks = nullptr, bool permq = false) {
  const int ntn = N >> 6;
  const int k0 = (t / ntn) << 6, n0 = (t % ntn) << 6;
  f32x4 v[16];
#pragma unroll
  for (int i = 0; i < 16; ++i) v[i] = *(const f32x4*)(src + (size_t)(k0 + 4 * i + (lane >> 4)) * N + n0 + 4 * (lane & 15));
#pragma unroll
  for (int i = 0; i < 16; ++i) {
    float* q = tl + (4 * i + (lane >> 4)) * 65 + 4 * (lane & 15);
    q[0] = v[i][0]; q[1] = v[i][1]; q[2] = v[i][2]; q[3] = v[i][3];
  }
  __builtin_amdgcn_fence(__ATOMIC_RELEASE, "wavefront");
  __builtin_amdgcn_wave_barrier();
  __builtin_amdgcn_fence(__ATOMIC_ACQUIRE, "wavefront");
#pragma unroll
  for (int i = 0; i < 8; ++i) {
    const int idx = lane + 64 * i, nn = idx >> 3, k8 = (idx & 7) * 8;
    float sc8[8];
#pragma unroll
    for (int q = 0; q < 8; ++q) sc8[q] = ks ? ks[k0 + k8 + q] : 1.f;
    u32x4 o;
    o[0] = pk2(tl[(k8 + 0) * 65 + nn] * sc8[0], tl[(k8 + 1) * 65 + nn] * sc8[1]);
    o[1] = pk2(tl[(k8 + 2) * 65 + nn] * sc8[2], tl[(k8 + 3) * 65 + nn] * sc8[3]);
    o[2] = pk2(tl[(k8 + 4) * 65 + nn] * sc8[4], tl[(k8 + 5) * 65 + nn] * sc8[5]);
    o[3] = pk2(tl[(k8 + 6) * 65 + nn] * sc8[6], tl[(k8 + 7) * 65 + nn] * sc8[7]);
    const int nrow = permq ? perm_uq(n0 + nn) : n0 + nn;
    *(u32x4*)(dst + (size_t)nrow * K + k0 + k8) = o;
  }
  __builtin_amdgcn_fence(__ATOMIC_RELEASE, "wavefront");
  __builtin_amdgcn_wave_barrier();
  __builtin_amdgcn_fence(__ATOMIC_ACQUIRE, "wavefront");
}
DI void transpose_mat(float* tl, const float* src, bf16_t* dst, int K, int N, int gw, int ngw, int lane, const float* ks = nullptr, bool permq = false) {
  const int nt = (K >> 6) * (N >> 6);
  for (int t = gw; t < nt; t += ngw) transpose_tile(tl, src, dst, K, N, t, lane, ks, permq);
}

DI void phase_prep(const Params& p, unsigned char* lds) {
  unsigned char* ws = p.ws;
  const int tid = TIDX(), lane = tid & 63, wave = tid >> 6;
  float* tl = (float*)lds + wave * (64 * 65);
  const int gw_t = blockIdx.x * 8 + wave, ngw_t = gridDim.x * 8;
  for (int e = 0; e < 2; ++e) {
    transpose_mat(tl, p.in[8] + (size_t)e * D * NPE, (bf16_t*)(ws + WS_WTIN_E) + (size_t)e * NPE * D, D, NPE, gw_t, ngw_t, lane);
    transpose_mat(tl, p.in[22] + (size_t)e * D * NVO, (bf16_t*)(ws + WS_WTIN_O) + (size_t)e * NPO * D, D, NVO, gw_t, ngw_t, lane);
    transpose_mat(tl, p.in[27] + (size_t)e * 512 * 1536, (bf16_t*)(ws + WS_WTUQ) + (size_t)e * 1536 * 512, 512, 1536, gw_t, ngw_t, lane, p.in[25] + e * 512, true);
    transpose_mat(tl, p.in[28] + (size_t)e * 256 * 2048, (bf16_t*)(ws + WS_WTUKV) + (size_t)e * 2048 * 256, 256, 2048, gw_t, ngw_t, lane, p.in[26] + e * 256, false);
    bf16_t* zp = (bf16_t*)(ws + WS_WTIN_O) + (size_t)e * NPO * D + (size_t)NVO * D;
    for (int i = blockIdx.x * NTH + tid; i < (NPO - NVO) * D / 8; i += gridDim.x * NTH) ((u32x4*)zp)[i] = (u32x4){0u, 0u, 0u, 0u};
  }
  for (int i = 0; i < 4; ++i) transpose_mat(tl, p.in[7] + (size_t)i * D * D, (bf16_t*)(ws + WS_WTOUT) + (size_t)i * D * D, D, D, gw_t, ngw_t, lane);
  {
    const float* cv = p.in[1]; const float* cc = p.in[3]; const float* aw = p.in[4]; const float* ab = p.in[5];
    float* mods = (float*)(ws + WS_MODS);
    for (int u = blockIdx.x; u < 4 * 64 * 3; u += gridDim.x) {
      const int i = u / 192, rem = u % 192, kc = rem / 3, nb = rem % 3;
      const int n = nb * 2048 + tid * 4;
      f32x4 al = {0.f, 0.f, 0.f, 0.f}, ac = {0.f, 0.f, 0.f, 0.f};
#pragma unroll
      for (int k8 = 0; k8 < 32; k8 += 8) {
        f32x4 w[8];
#pragma unroll
        for (int q = 0; q < 8; ++q) w[q] = *(const f32x4*)(aw + ((size_t)i * D + kc * 32 + k8 + q) * 6144 + n);
#pragma unroll
        for (int q = 0; q < 8; ++q) { const int k = kc * 32 + k8 + q; const float a = silu_f(cv[k]), b = silu_f(cc[k]); al += a * w[q]; ac += b * w[q]; }
      }
      if (kc == 0) { const f32x4 bb = *(const f32x4*)(ab + i * 6144 + n); al += bb; ac += bb; }
#pragma unroll
      for (int j = 0; j < 4; ++j) { atomicAdd(&mods[(i * 2 + 0) * 6144 + n + j], al[j]); atomicAdd(&mods[(i * 2 + 1) * 6144 + n + j], ac[j]); }
    }
  }
  {
    c32* TW = (c32*)(ws + WS_TW);
    for (int m = blockIdx.x * NTH + tid; m < FN; m += gridDim.x * NTH) {
      float sn, cs; sincospif(2.f * (float)m / (float)FN, &sn, &cs);
      TW[m] = {cs, -sn};
    }
  }
  {
    float* ct = (float*)(ws + WS_ROPE); float* st = ct + (size_t)SEQ * 64;
    for (int i = blockIdx.x * NTH + tid; i < SEQ * 64; i += gridDim.x * NTH) {
      const int t = i >> 6, j = i & 63;
      const float inv = powf(10000.f, -(float)(j & 31) / 32.f);
      const float ang = (float)(j < 32 ? (t >> 6) : (t & 63)) * inv;
      float sn, cs; sincosf(ang, &sn, &cs);
      ct[i] = cs; st[i] = sn;
    }
  }
  {
    float* ct = (float*)(ws + WS_ROPE64); float* st = ct + (size_t)SEQ * 32;
    for (int i = blockIdx.x * NTH + tid; i < SEQ * 32; i += gridDim.x * NTH) {
      const int t = i >> 5, j = i & 31;
      const float inv = powf(10000.f, -(float)(j & 15) / 16.f);
      const float ang = (float)(j < 16 ? (t >> 6) : (t & 63)) * inv;
      float sn, cs; sincosf(ang, &sn, &cs);
      ct[i] = cs; st[i] = sn;
    }
  }
  {
    const int gw = blockIdx.x * 8 + wave, ngw = gridDim.x * 8;
    for (int u = gw; u < 2 * (SEQ + CTX); u += ngw) {
      const int e = u / (SEQ + CTX), rr = u % (SEQ + CTX);
      const int L = rr < SEQ ? SEQ : CTX, r = rr < SEQ ? rr : rr - SEQ;
      float* hid = rr < SEQ ? (float*)(ws + WS_HID) + ((size_t)e * SEQ + r) * 64 : (float*)(ws + WS_HID256) + ((size_t)e * CTX + r) * 64;
      const float* w1 = p.in[14] + e * 33 * 64; const float* b1 = p.in[15] + e * 64; const float* f1 = p.in[16] + e * 64;
      const float* w2 = p.in[17] + e * 64 * 64; const float* b2 = p.in[18] + e * 64; const float* f2 = p.in[19] + e * 64;
      const float tt = (float)r / (float)(L - 1);
      const int b = lane & 15;
      const float band = 1e-4f + (15.f - 1e-4f) * (float)b / 15.f;
      const float cst = (float)(6.283185307179586 / (double)L);
      const float ang = (cst * (float)r) * band;
      float sn, cs; sincosf(ang, &sn, &cs);
      const float val = (lane < 16) ? cs : -sn;
      float acc = b1[lane] + tt * w1[lane];
      for (int f = 1; f < 33; ++f) acc += __shfl(val, f - 1) * w1[f * 64 + lane];
      const float h1 = sinf(f1[lane] * acc);
      float acc2 = b2[lane];
      for (int i = 0; i < 64; ++i) acc2 += __shfl(h1, i) * w2[i * 64 + lane];
      hid[lane] = sinf(f2[lane] * acc2);
    }
  }
}

DI const float* norm_src(const Params& p, int layer, int m) {
  if (layer == 0) return m < CTX ? p.in[2] + (size_t)m * D : p.in[0] + (size_t)(m - CTX) * D;
  return (const float*)(p.ws + WS_H) + (size_t)m * D;
}
DI void phase_norm(const Params& p, int layer) {
  const int tid_ = TIDX(); const int lane = tid_ & 63, wave = tid_ >> 6;
  const int gw = blockIdx.x * 8 + wave, ngw = gridDim.x * 8;
  const float* ng = p.in[6] + layer * D;
  bf16_t* U = (bf16_t*)(p.ws + WS_U);
  f32x4 vn[8];
  if (gw < MR) {
    const float* s0 = norm_src(p, layer, gw);
#pragma unroll
    for (int i = 0; i < 8; ++i) vn[i] = *(const f32x4*)(s0 + (lane + 64 * i) * 4);
  }
  for (int m = gw; m < MR; m += ngw) {
    float* hr = (float*)(p.ws + WS_H) + (size_t)m * D;
    const float* mod = (const float*)(p.ws + WS_MODS) + (size_t)(layer * 2 + (m < CTX ? 1 : 0)) * 6144;
    f32x4 v[8]; float ss = 0.f;
#pragma unroll
    for (int i = 0; i < 8; ++i) { v[i] = vn[i]; ss += v[i][0] * v[i][0] + v[i][1] * v[i][1] + v[i][2] * v[i][2] + v[i][3] * v[i][3]; }
    if (m + ngw < MR) {
      const float* s1 = norm_src(p, layer, m + ngw);
#pragma unroll
      for (int i = 0; i < 8; ++i) vn[i] = *(const f32x4*)(s1 + (lane + 64 * i) * 4);
    }
    if (layer > 0 && m < CTX) {
      const float* gm = (const float*)(p.ws + WS_MODS) + (size_t)((layer - 1) * 2 + 1) * 6144 + 4096;
      const float* part = (const float*)(p.ws + WS_PART) + (size_t)m * D;
      ss = 0.f;
#pragma unroll
      for (int i = 0; i < 8; ++i) {
        const int n = (lane + 64 * i) * 4;
        f32x4 a = *(const f32x4*)(part + n);
#pragma unroll
        for (int kp = 1; kp < 8; ++kp) a += *(const f32x4*)(part + (size_t)kp * CTX * D + n);
        const f32x4 g = *(const f32x4*)(gm + n);
        v[i] += g * a;
        ss += v[i][0] * v[i][0] + v[i][1] * v[i][1] + v[i][2] * v[i][2] + v[i][3] * v[i][3];
      }
    }
    if (layer == 0 || m < CTX) {
#pragma unroll
      for (int i = 0; i < 8; ++i) *(f32x4*)(hr + (lane + 64 * i) * 4) = v[i];
    }
    ss = wave_sum(ss);
    const float rs = rsqrtf(ss * (1.f / D) + EPS);
#pragma unroll
    for (int i = 0; i < 8; ++i) {
      const int n = (lane + 64 * i) * 4;
      const f32x4 g = *(const f32x4*)(ng + n), sh = *(const f32x4*)(mod + n), sc = *(const f32x4*)(mod + 2048 + n);
      float o[4];
#pragma unroll
      for (int j = 0; j < 4; ++j) o[j] = v[i][j] * rs * g[j] * (1.f + sc[j]) + sh[j];
      u32x2 w; w[0] = pk2(o[0], o[1]); w[1] = pk2(o[2], o[3]);
      *(u32x2*)(U + (size_t)m * D + n) = w;
    }
  }
}

DI void taps_unit(const float* __restrict__ hid, int L, const float* __restrict__ w3, float* __restrict__ taps, int rt, int ct0, int nct, int lane) {
  const int h = lane >> 5, l31 = lane & 31;
  const int r = rt * 32 + l31;
  float a[32], b[32];
#pragma unroll
  for (int st = 0; st < 32; ++st) a[st] = hid[(size_t)r * 64 + 2 * st + h];
  const float tr = -LOG2E * (float)r / (float)(L - 1);
  const unsigned woff = (unsigned)(h * 4096 + l31);
#pragma unroll
  for (int st = 0; st < 32; ++st) b[st] = w3[woff + (unsigned)(st * 8192 + ct0 * 32)];
  for (int ct = ct0; ct < ct0 + nct; ++ct) {
    f32x16 acc;
#pragma unroll
    for (int i = 0; i < 16; ++i) acc[i] = 0.f;
#pragma unroll
    for (int st = 0; st < 32; ++st) acc = __builtin_amdgcn_mfma_f32_32x32x2f32(b[st], a[st], acc, 0, 0, 0);
    if (ct + 1 < ct0 + nct) {
#pragma unroll
      for (int st = 0; st < 32; ++st) b[st] = w3[woff + (unsigned)(st * 8192 + (ct + 1) * 32)];
    }
    const int cbase = ct * 32;
    const int o = cbase >> 11, side = (cbase >> 10) & 1;
    float* kp0 = taps + (size_t)(o * 1024 + (cbase & 1023)) * (2 * L);
    const unsigned pos = side == 0 ? (unsigned)r : (r == 0 ? (unsigned)L : (unsigned)(2 * L - r));
#pragma unroll
    for (int i = 0; i < 16; ++i) {
      const int chl = crow(i, h);
      const float delta = DECAY_MAX + (DECAY_MIN - DECAY_MAX) * ((float)((cbase & 1023) + chl) / 1023.f);
      float v = acc[i] * __builtin_amdgcn_exp2f(tr * delta);
      if (side != 0 && r == 0) v = 0.f;
      kp0[(unsigned)(chl * 2 * L) + pos] = v;
    }
  }
}
DI void phase_taps(const Params& p, int e, int b0) {
  const int vb = vblock();
  if (vb < b0) return;
  const int tid_ = TIDX(); const int lane = tid_ & 63, wave = tid_ >> 6;
  const int gw = (vb - b0) * 8 + wave, ngw = ((int)gridDim.x - b0) * 8;
  const float* w3 = p.in[20] + (size_t)e * 64 * 4096;
  for (int u = gw; u < 2048 + 1024; u += ngw) {
    if (u < 2048) taps_unit((const float*)(p.ws + WS_HID) + (size_t)e * SEQ * 64, SEQ, w3, (float*)(p.ws + WS_TAPS), u >> 3, (u & 7) * 16, 16, lane);
    else { const int v = u - 2048; taps_unit((const float*)(p.ws + WS_HID256) + (size_t)e * CTX * 64, CTX, w3, (float*)(p.ws + WS_TAPS256), v >> 7, v & 127, 1, lane); }
  }
}


DI const Params& kargs() {
  const void* q = (const void*)__builtin_amdgcn_kernarg_segment_ptr();
  asm volatile("" : "+s"(q));
  return *(const Params*)q;
}
#define PP kargs()
struct TileFuse { int mode; int e; };
DI void head128_tile(const f32x16 (&acc)[4][2], int mt, int wm, int lane, const float* gv, float post, bool rope, const float* cosT, const float* sinT,
                     const float* rowsq, float rdim, bf16_t* dst, int ld, int col0) {
  const int h = lane >> 5, l31 = lane & 31;
#pragma unroll
  for (int j = 0; j < 2; ++j) {
    const int m = mt * 256 + wm * 64 + j * 32 + l31;
    const bool lat = rope && m >= CTX;
    const float pre = rowsq ? rsqrtf(rowsq[m] * rdim + EPS) : 1.f;
    float ss = 0.f;
#pragma unroll
    for (int i = 0; i < 4; ++i)
#pragma unroll
      for (int r = 0; r < 16; ++r) ss += acc[i][j][r] * acc[i][j][r];
    ss += __shfl_xor(ss, 32);
    const float rs = rsqrtf(ss * pre * pre * (1.f / 128.f) + EPS) * post * pre;
    const float* cr = cosT + (size_t)(lat ? m - CTX : 0) * 64; const float* sr = sinT + (size_t)(lat ? m - CTX : 0) * 64;
    bf16_t* prow = dst + (size_t)m * ld + col0;
#pragma unroll
    for (int i = 0; i < 2; ++i)
#pragma unroll
      for (int g = 0; g < 4; ++g) {
        const int d0 = i * 32 + 8 * g + 4 * h;
        const f32x4 ga = *(const f32x4*)(gv + d0), gb = *(const f32x4*)(gv + d0 + 64);
        f32x4 c4 = {1.f, 1.f, 1.f, 1.f}, s4 = {0.f, 0.f, 0.f, 0.f};
        if (lat) { c4 = *(const f32x4*)(cr + d0); s4 = *(const f32x4*)(sr + d0); }
        float y0[4], y1[4];
#pragma unroll
        for (int jj = 0; jj < 4; ++jj) {
          const float a = acc[i][j][4 * g + jj] * rs * ga[jj], b = acc[i + 2][j][4 * g + jj] * rs * gb[jj];
          y0[jj] = a * c4[jj] - b * s4[jj]; y1[jj] = b * c4[jj] + a * s4[jj];
        }
        u32x2 w0, w1; w0[0] = pk2(y0[0], y0[1]); w0[1] = pk2(y0[2], y0[3]); w1[0] = pk2(y1[0], y1[1]); w1[1] = pk2(y1[2], y1[3]);
        *(u32x2*)(prow + d0) = w0; *(u32x2*)(prow + d0 + 64) = w1;
      }
  }
}
DI void head64_tile(const f32x16 (&acc)[4][2], int i0, int mt, int wm, int lane, const float* gv, float post, const float* cosT, const float* sinT,
                    const float* rowsq, float rdim, bf16_t* dst, int ld, int col0) {
  const int h = lane >> 5, l31 = lane & 31;
#pragma unroll
  for (int j = 0; j < 2; ++j) {
    const int m = mt * 256 + wm * 64 + j * 32 + l31;
    const bool lat = m >= CTX;
    const float pre = rowsq ? rsqrtf(rowsq[m] * rdim + EPS) : 1.f;
    float ss = 0.f;
#pragma unroll
    for (int r = 0; r < 16; ++r) ss += acc[i0][j][r] * acc[i0][j][r] + acc[i0 + 1][j][r] * acc[i0 + 1][j][r];
    ss += __shfl_xor(ss, 32);
    const float rs = rsqrtf(ss * pre * pre * (1.f / 64.f) + EPS) * post * pre;
    const float* cr = cosT + (size_t)(lat ? m - CTX : 0) * 32; const float* sr = sinT + (size_t)(lat ? m - CTX : 0) * 32;
    bf16_t* prow = dst + (size_t)m * ld + col0;
#pragma unroll
    for (int g = 0; g < 4; ++g) {
      const int d0 = 8 * g + 4 * h;
      const f32x4 ga = *(const f32x4*)(gv + d0), gb = *(const f32x4*)(gv + d0 + 32);
      f32x4 c4 = {1.f, 1.f, 1.f, 1.f}, s4 = {0.f, 0.f, 0.f, 0.f};
      if (lat) { c4 = *(const f32x4*)(cr + d0); s4 = *(const f32x4*)(sr + d0); }
      float y0[4], y1[4];
#pragma unroll
      for (int jj = 0; jj < 4; ++jj) {
        const float a = acc[i0][j][4 * g + jj] * rs * ga[jj], b = acc[i0 + 1][j][4 * g + jj] * rs * gb[jj];
        y0[jj] = a * c4[jj] - b * s4[jj]; y1[jj] = b * c4[jj] + a * s4[jj];
      }
      u32x2 w0, w1; w0[0] = pk2(y0[0], y0[1]); w0[1] = pk2(y0[2], y0[3]); w1[0] = pk2(y1[0], y1[1]); w1[1] = pk2(y1[2], y1[3]);
      *(u32x2*)(prow + d0) = w0; *(u32x2*)(prow + d0 + 32) = w1;
    }
  }
}
DI void plain_tile(const f32x16 (&acc)[4][2], int i_lo, int i_hi, int mt, int wm, int lane, bf16_t* dst, int ld, int col0) {
  const int h = lane >> 5, l31 = lane & 31;
#pragma unroll
  for (int i = 0; i < 4; ++i) {
    if (i < i_lo || i >= i_hi) continue;
#pragma unroll
    for (int j = 0; j < 2; ++j)
#pragma unroll
      for (int g = 0; g < 4; ++g) {
        const int m = mt * 256 + wm * 64 + j * 32 + l31;
        u32x2 w; w[0] = pk2(acc[i][j][4 * g], acc[i][j][4 * g + 1]); w[1] = pk2(acc[i][j][4 * g + 2], acc[i][j][4 * g + 3]);
        *(u32x2*)(dst + (size_t)m * ld + col0 + i * 32 + 8 * g + 4 * h) = w;
      }
  }
}
DI bool fused_tile(const f32x16 (&acc)[4][2], int nt, int mt, int wn, int wm, int lane, const TileFuse& tf) {
  const int h = lane >> 5, l31 = lane & 31;
  const int col0 = nt * 256 + wn * 128;
  const int mode = tf.mode, e = tf.e;
  if (mode <= 1) {
    if (!(nt <= 4 || (mode == 1 && nt >= 6 && nt <= 9))) return false;
    const Params& p = kargs();
    bf16_t* dst = (bf16_t*)(p.ws + WS_P); const int ld = mode == 1 ? NPO : NPE;
    const float* cos128 = (const float*)(p.ws + WS_ROPE); const float* sin128 = cos128 + (size_t)SEQ * 64;
    if (nt < 4) { head128_tile(acc, mt, wm, lane, (mode == 1 ? p.in[23] : p.in[9]) + e * 128, QSCALE128, true, cos128, sin128, nullptr, 0.f, dst, ld, col0); return true; }
    if (nt == 4) { head128_tile(acc, mt, wm, lane, (mode == 1 ? p.in[24] : p.in[10]) + e * 128, 1.f, true, cos128, sin128, nullptr, 0.f, dst, ld, col0); return true; }
    if (nt <= 8) {
      plain_tile(acc, 0, 4, mt, wm, lane, dst, ld, col0);
      float* rq = (float*)(p.ws + WS_ROWSQ) + (size_t)e * 2 * MR + (nt == 8 ? MR : 0);
#pragma unroll
      for (int j = 0; j < 2; ++j) {
        float ss = 0.f;
#pragma unroll
        for (int i = 0; i < 4; ++i)
#pragma unroll
          for (int r = 0; r < 16; ++r) ss += acc[i][j][r] * acc[i][j][r];
        ss += __shfl_xor(ss, 32);
        if (h == 0) atomicAdd(rq + mt * 256 + wm * 64 + j * 32 + l31, ss);
      }
      return true;
    }
    if (wn == 0) {
      const float* c64 = (const float*)(p.ws + WS_ROPE64);
      head64_tile(acc, 0, mt, wm, lane, p.in[30] + e * 192 + 128, 1.f, c64, c64 + (size_t)SEQ * 32, nullptr, 0.f, dst, ld, col0);
      plain_tile(acc, 2, 4, mt, wm, lane, dst, ld, col0);
    } else plain_tile(acc, 0, 4, mt, wm, lane, dst, ld, col0);
    return true;
  }
  const Params& p = kargs();
  const float* rowsq = (const float*)(p.ws + WS_ROWSQ) + (size_t)e * 2 * MR + (mode == 3 ? MR : 0);
  if (mode == 2) {
    bf16_t* dst = (bf16_t*)(p.ws + WS_QM);
    if (nt < 4) head128_tile(acc, mt, wm, lane, p.in[29] + e * 192, QSCALE192, false, nullptr, nullptr, rowsq, 1.f / 512.f, dst, 1536, col0);
    else {
      const float* c64 = (const float*)(p.ws + WS_ROPE64);
      head64_tile(acc, 0, mt, wm, lane, p.in[29] + e * 192 + 128, QSCALE192, c64, c64 + (size_t)SEQ * 32, rowsq, 1.f / 512.f, dst, 1536, col0);
      head64_tile(acc, 2, mt, wm, lane, p.in[29] + e * 192 + 128, QSCALE192, c64, c64 + (size_t)SEQ * 32, rowsq, 1.f / 512.f, dst, 1536, col0 + 64);
    }
    return true;
  }
  if (wn == 0) { head128_tile(acc, mt, wm, lane, p.in[30] + e * 192, 1.f, false, nullptr, nullptr, rowsq, 1.f / 256.f, (bf16_t*)(p.ws + WS_KV), 2048, nt * 256); return true; }
  bf16_t* vmt = (bf16_t*)(p.ws + WS_VMT);
#pragma unroll
  for (int j = 0; j < 2; ++j) {
    const int m = mt * 256 + wm * 64 + j * 32 + l31;
    const float pre = rsqrtf(rowsq[m] * (1.f / 256.f) + EPS);
#pragma unroll
    for (int i = 0; i < 4; ++i)
#pragma unroll
      for (int r = 0; r < 16; ++r) vmt[(size_t)(nt * 128 + i * 32 + crow(r, h)) * MR + m] = f2bf(acc[i][j][r] * pre);
  }
  return true;
}

template <class Epi>
DI void gemm_phase(unsigned char* lds, const bf16_t* __restrict__ W, int ldw, const bf16_t* __restrict__ X, int ldx, int N, int M, int K, int mt_begin, const Epi epi, int ksplit = 1, const TileFuse* tf = nullptr) {
  const int tid = TIDX(), lane = tid & 63, wave = tid >> 6, h = lane >> 5, l31 = lane & 31;
  const int wn = wave >> 2, wm = wave & 3;
  const int NTm = M / 256 - mt_begin, NTn = N / 256;
  const int ntiles = NTn * NTm * ksplit, nk = K / 64 / ksplit;
  const int srow = tid >> 3, scn = tid & 7;
  const int soff = srow * 128 + ((scn ^ ((srow >> 1) & 7)) << 4);
  for (int tile = vblock(); tile < ntiles; tile += gridDim.x) {
    const int kp = tile % ksplit, t2 = tile / ksplit;
    const int pg = t2 / (4 * NTm), pr = t2 % (4 * NTm), gsz = (NTn - 4 * pg) < 4 ? (NTn - 4 * pg) : 4;
    const int nt = 4 * pg + pr % gsz, mt = pr / gsz + mt_begin;
    const int cgl = scn ^ ((srow >> 1) & 7);
    const bf16_t* Wp = W + (size_t)(nt * 256 + srow) * ldw + cgl * 8 + kp * nk * 64;
    const bf16_t* Xp = X + (size_t)(mt * 256 + srow) * ldx + cgl * 8 + kp * nk * 64;
    f32x16 acc[4][2];
#pragma unroll
    for (int i = 0; i < 4; ++i)
#pragma unroll
      for (int j = 0; j < 2; ++j)
#pragma unroll
        for (int r = 0; r < 16; ++r) acc[i][j][r] = 0.f;
#define GEMM_STAGE(buf, kt_) do { \
      _Pragma("unroll") for (int i = 0; i < 4; ++i) { \
        __builtin_amdgcn_global_load_lds((const unsigned*)(Wp + (size_t)(64 * i) * ldw + (kt_) * 64), (unsigned*)((buf) + tid * 16 + i * 8192), 16, 0, 0); \
        __builtin_amdgcn_global_load_lds((const unsigned*)(Xp + (size_t)(64 * i) * ldx + (kt_) * 64), (unsigned*)((buf) + 32768 + tid * 16 + i * 8192), 16, 0, 0); } } while (0)
    GEMM_STAGE(lds, 0);
    __syncthreads();
    for (int kt = 0; kt < nk; ++kt) {
      unsigned char* cur = lds + (kt & 1) * 65536;
      unsigned char* nxt = lds + ((kt + 1) & 1) * 65536;
      if (kt + 1 < nk) GEMM_STAGE(nxt, kt + 1);
      __builtin_amdgcn_sched_barrier(0);
#pragma unroll
      for (int s = 0; s < 4; ++s) {
        const int c = ((2 * s + h) ^ ((l31 >> 1) & 7)) << 4;
        bf16x8 a[4], b[2];
#pragma unroll
        for (int i = 0; i < 4; ++i) a[i] = *(const bf16x8*)(cur + (wn * 128 + i * 32 + l31) * 128 + c);
#pragma unroll
        for (int j = 0; j < 2; ++j) b[j] = *(const bf16x8*)(cur + 32768 + (wm * 64 + j * 32 + l31) * 128 + c);
#pragma unroll
        for (int i = 0; i < 4; ++i)
#pragma unroll
          for (int j = 0; j < 2; ++j) acc[i][j] = MFMA16(a[i], b[j], acc[i][j]);
      }
      __syncthreads();
    }
#undef GEMM_STAGE
    if (tf != nullptr && fused_tile(acc, nt, mt, wn, wm, lane, *tf)) continue;
#pragma unroll
    for (int i = 0; i < 4; ++i)
#pragma unroll
      for (int j = 0; j < 2; ++j)
#pragma unroll
        for (int g = 0; g < 4; ++g) {
          const int n = nt * 256 + wn * 128 + i * 32 + 8 * g + 4 * h;
          const int m = mt * 256 + wm * 64 + j * 32 + l31;
          epi(m, n, acc[i][j][4 * g], acc[i][j][4 * g + 1], acc[i][j][4 * g + 2], acc[i][j][4 * g + 3], kp);
        }
  }
}
struct EpiIn {
  bf16_t* P; int ldp; int nvalid; bf16_t* Vt; bf16_t* PT; int hy_lo, hy_hi; bf16_t* GT; int gt_lo;
  DI void operator()(int m, int n, float a, float b, float c, float d, int kp) const {
    if (n >= nvalid) return;
    bf16_t* v = nullptr;
    if (n >= 1280 && n < 1536) v = Vt + (size_t)(n - 1280) * MR + m;
    else if (n >= hy_lo && n < hy_hi) v = PT + (size_t)(n - hy_lo) * MR + m;
    else if (n >= gt_lo) v = GT + (size_t)(n - gt_lo) * MR + m;
    if (v != nullptr) { v[0] = f2bf(a); v[MR] = f2bf(b); v[2 * MR] = f2bf(c); v[3 * MR] = f2bf(d); }
    else {
      u32x2 w; w[0] = pk2(a, b); w[1] = pk2(c, d);
      *(u32x2*)(P + (size_t)m * ldp + n) = w;
    }
  }
};
struct EpiUQ {
  bf16_t* Q;
  DI void operator()(int m, int n, float a, float b, float c, float d, int kp) const {
    u32x2 w; w[0] = pk2(a, b); w[1] = pk2(c, d);
    *(u32x2*)(Q + (size_t)m * 1536 + n) = w;
  }
};
struct EpiUKV {
  bf16_t* KV; bf16_t* Vmt;
  DI void operator()(int m, int n, float a, float b, float c, float d, int kp) const {
    const int w_ = n & 255, hd = n >> 8;
    if (w_ >= 128) {
      bf16_t* v = Vmt + (size_t)(hd * 128 + w_ - 128) * MR + m;
      v[0] = f2bf(a); v[MR] = f2bf(b); v[2 * MR] = f2bf(c); v[3 * MR] = f2bf(d);
    } else {
      u32x2 w; w[0] = pk2(a, b); w[1] = pk2(c, d);
      *(u32x2*)(KV + (size_t)m * 2048 + n) = w;
    }
  }
};
struct EpiOut {
  float* H; float* dout; const float* mods; int layer;
  DI void operator()(int m, int n, float a, float b, float c, float d, int kp) const {
    const f32x4 hv = *(const f32x4*)(H + (size_t)m * D + n);
    const f32x4 g = *(const f32x4*)(mods + (size_t)(layer * 2 + (m < CTX ? 1 : 0)) * 6144 + 4096 + n);
    f32x4 o; o[0] = hv[0] + g[0] * a; o[1] = hv[1] + g[1] * b; o[2] = hv[2] + g[2] * c; o[3] = hv[3] + g[3] * d;
    if (layer == 3) { if (m >= CTX) *(f32x4*)(dout + (size_t)(m - CTX) * D + n) = o; }
    else *(f32x4*)(H + (size_t)m * D + n) = o;
  }
};

struct EpiOutPart {
  float* PART;
  DI void operator()(int m, int n, float a, float b, float c, float d, int kp) const {
    *(f32x4*)(PART + ((size_t)kp * CTX + m) * D + n) = (f32x4){a, b, c, d};
  }
};

DI void head_norm128(bf16_t* px, const float* g, bool rope, float cs, float sn, int lane) {
  const float x0 = bf2f(px[lane]), x1 = bf2f(px[lane + 64]);
  const float ss = wave_sum(x0 * x0 + x1 * x1);
  const float rs = rsqrtf(ss * (1.f / 128.f) + EPS);
  float y0 = x0 * rs * g[lane], y1 = x1 * rs * g[lane + 64];
  if (rope) { const float a = y0 * cs - y1 * sn, b = y1 * cs + y0 * sn; y0 = a; y1 = b; }
  px[lane] = f2bf(y0); px[lane + 64] = f2bf(y1);
}
DI void head_norm64(bf16_t* px, const float* g, bool rope, float cs, float sn, int lane) {
  float x0 = 0.f, x1 = 0.f;
  if (lane < 32) { x0 = bf2f(px[lane]); x1 = bf2f(px[lane + 32]); }
  const float ss = wave_sum(x0 * x0 + x1 * x1);
  const float rs = rsqrtf(ss * (1.f / 64.f) + EPS);
  if (lane < 32) {
    float y0 = x0 * rs * g[lane], y1 = x1 * rs * g[lane + 32];
    if (rope) { const float a = y0 * cs - y1 * sn, b = y1 * cs + y0 * sn; y0 = a; y1 = b; }
    px[lane] = f2bf(y0); px[lane + 32] = f2bf(y1);
  }
}

template <int NH>
DI void heads_norm128(bf16_t* base, int stride, const float* g, bool rope, float cs, float sn, int lane, float post = 1.f) {
  float x0[NH], x1[NH];
#pragma unroll
  for (int i = 0; i < NH; ++i) { x0[i] = bf2f(base[i * stride + lane]); x1[i] = bf2f(base[i * stride + lane + 64]); }
  const float g0 = g[lane], g1 = g[lane + 64];
  float ss[NH];
#pragma unroll
  for (int i = 0; i < NH; ++i) ss[i] = x0[i] * x0[i] + x1[i] * x1[i];
#pragma unroll
  for (int o = 32; o > 0; o >>= 1) {
#pragma unroll
    for (int i = 0; i < NH; ++i) ss[i] += __shfl_xor(ss[i], o);
  }
#pragma unroll
  for (int i = 0; i < NH; ++i) {
    const float rs = rsqrtf(ss[i] * (1.f / 128.f) + EPS) * post;
    float y0 = x0[i] * rs * g0, y1 = x1[i] * rs * g1;
    if (rope) { const float a = y0 * cs - y1 * sn, b = y1 * cs + y0 * sn; y0 = a; y1 = b; }
    base[i * stride + lane] = f2bf(y0); base[i * stride + lane + 64] = f2bf(y1);
  }
}
template <int NH>
DI void heads_norm64(bf16_t* base, int stride, const float* g, bool rope, float cs, float sn, int lane, float post = 1.f) {
  float x0[NH], x1[NH];
  const int l = lane & 31;
#pragma unroll
  for (int i = 0; i < NH; ++i) { x0[i] = bf2f(base[i * stride + l]); x1[i] = bf2f(base[i * stride + l + 32]); }
  const float g0 = g[l], g1 = g[l + 32];
  float ss[NH];
#pragma unroll
  for (int i = 0; i < NH; ++i) ss[i] = x0[i] * x0[i] + x1[i] * x1[i];
#pragma unroll
  for (int o = 16; o > 0; o >>= 1) {
#pragma unroll
    for (int i = 0; i < NH; ++i) ss[i] += __shfl_xor(ss[i], o);
  }
  if (lane < 32) {
#pragma unroll
    for (int i = 0; i < NH; ++i) {
      const float rs = rsqrtf(ss[i] * (1.f / 64.f) + EPS) * post;
      float y0 = x0[i] * rs * g0, y1 = x1[i] * rs * g1;
      if (rope) { const float a = y0 * cs - y1 * sn, b = y1 * cs + y0 * sn; y0 = a; y1 = b; }
      base[i * stride + l] = f2bf(y0); base[i * stride + l + 32] = f2bf(y1);
    }
  }
}
DI void rope_angles(int t, int lane, float& cs128, float& sn128, float& cs64, float& sn64) {
  const int row = t >> 6, col = t & 63;
  {
    const int f = lane & 31;
    const float inv = powf(10000.f, -(float)f / 32.f);
    const float ang = (float)(lane < 32 ? row : col) * inv;
    sincosf(ang, &sn128, &cs128);
  }
  {
    const int j = lane & 31, f = j & 15;
    const float inv = powf(10000.f, -(float)f / 16.f);
    const float ang = (float)(j < 16 ? row : col) * inv;
    sincosf(ang, &sn64, &cs64);
  }
}
DI void phase_rowops(const Params& p, int layer) {
  const int tid_ = TIDX(); const int lane = tid_ & 63, wave = tid_ >> 6;
  const int gw = blockIdx.x * 8 + wave, ngw = gridDim.x * 8;
  const bool odd = layer & 1; const int e = layer >> 1;
  const int ld = odd ? NPO : NPE;
  bf16_t* P = (bf16_t*)(p.ws + WS_P);
  const float* qg = (odd ? p.in[23] : p.in[9]) + e * 128;
  const float* kg = (odd ? p.in[24] : p.in[10]) + e * 128;
  for (int m = gw; m < MR; m += ngw) {
    const bool lat = m >= CTX;
    float cs128 = 1.f, sn128 = 0.f, cs64 = 1.f, sn64 = 0.f;
    if (lat) rope_angles(m - CTX, lane, cs128, sn128, cs64, sn64);
    bf16_t* row = P + (size_t)m * ld;
    if (odd) {
      {
        const float* g = p.in[25] + e * 512;
        bf16_t* px = row + 1536 + lane * 8;
        float x[8]; float ss = 0.f;
#pragma unroll
        for (int j = 0; j < 8; ++j) { x[j] = bf2f(px[j]); ss += x[j] * x[j]; }
        ss = wave_sum(ss);
        const float rs = rsqrtf(ss * (1.f / 512.f) + EPS);
#pragma unroll
        for (int j = 0; j < 8; ++j) px[j] = f2bf(x[j] * rs * g[lane * 8 + j]);
      }
      {
        const float* g = p.in[26] + e * 256;
        bf16_t* px = row + 2048 + lane * 4;
        float x[4]; float ss = 0.f;
#pragma unroll
        for (int j = 0; j < 4; ++j) { x[j] = bf2f(px[j]); ss += x[j] * x[j]; }
        ss = wave_sum(ss);
        const float rs = rsqrtf(ss * (1.f / 256.f) + EPS);
#pragma unroll
        for (int j = 0; j < 4; ++j) px[j] = f2bf(x[j] * rs * g[lane * 4 + j]);
      }
      heads_norm64<1>(row + 2304, 0, p.in[30] + e * 192 + 128, lat, cs64, sn64, lane);
    }
  }
}
DI void phase_mla_norm(const Params& p, int layer) {
  const int tid_ = TIDX(); const int lane = tid_ & 63, wave = tid_ >> 6;
  const int gw = blockIdx.x * 8 + wave, ngw = gridDim.x * 8;
  const int e = layer >> 1;
  bf16_t* QM = (bf16_t*)(p.ws + WS_QM); bf16_t* KV = (bf16_t*)(p.ws + WS_KV);
  const float* mqg = p.in[29] + e * 192; const float* mkg = p.in[30] + e * 192;
  for (int m = gw; m < MR; m += ngw) {
    const bool lat = m >= CTX;
    float cs128 = 1.f, sn128 = 0.f, cs64 = 1.f, sn64 = 0.f;
    if (lat) rope_angles(m - CTX, lane, cs128, sn128, cs64, sn64);
    heads_norm128<8>(QM + (size_t)m * 1536, 192, mqg, false, 1.f, 0.f, lane, QSCALE192);
    heads_norm64<8>(QM + (size_t)m * 1536 + 128, 192, mqg + 128, lat, cs64, sn64, lane, QSCALE192);
    heads_norm128<8>(KV + (size_t)m * 2048, 256, mkg, false, 1.f, 0.f, lane);
  }
}

DI float block_sum(float v, float* red, int tid) {
  v = wave_sum(v);
  __syncthreads();
  if ((tid & 63) == 0) red[tid >> 6] = v;
  __syncthreads();
  float s = 0.f;
#pragma unroll
  for (int i = 0; i < 8; ++i) s += red[i];
  return s;
}
DI float conv3_at(const bf16_t* pc, int t, float w0, float w1, float w2, float b) {
  const float pm = bf2f(pc[t - 1]), p0 = bf2f(pc[t]), pp = bf2f(pc[t + 1]);
  return w0 * (t > 0 ? pm : 0.f) + w1 * p0 + w2 * (t < SEQ - 1 ? pp : 0.f) + b;
}
DI int rev4(int x) { const unsigned r = __brev((unsigned)x) >> 18; return (int)(((r & 0x2AAAu) >> 1) | ((r & 0x1555u) << 1)); }
DI void hyena_item(const Params& p, unsigned char* lds, int e, int it) {
  c32* X = (c32*)lds; float* red = (float*)(lds + LDS_RED);
  const c32* TW = (const c32*)(lds + LDS_WT);
  const bf16_t* PT = (const bf16_t*)(p.ws + WS_XT);
  const bf16_t* GTp = (const bf16_t*)(p.ws + WS_YT);
  bf16_t* O = (bf16_t*)(p.ws + WS_O);
  const float* hb = p.in[21] + (size_t)e * 2 * 1024;
  const float* cw = p.in[12] + (size_t)e * 3 * 3072; const float* cb = p.in[13] + (size_t)e * 3072;
  unsigned outp[16];
  for (int c = 0; c < 4; ++c) {
    const int ch = 4 * it + c;
    float zreg[16];
    for (int o = 0; o < 2; ++o) {
      const int tid = TIDX();
      const float* tp = (const float*)(p.ws + WS_TAPS) + (size_t)(o * 1024 + ch) * FN;
      float kv[32];
#pragma unroll
      for (int m = 0; m < 32; ++m) kv[m] = tp[tid + NTH * m];
      if (o == 0) {
        const int col = 2048 + ch;
        const bf16_t* pc = PT + (size_t)col * MR + CTX;
        const float w0 = cw[col], w1 = cw[3072 + col], w2 = cw[2 * 3072 + col], bb = cb[col];
#pragma unroll
        for (int m = 0; m < 16; ++m) zreg[m] = conv3_at(pc, tid + NTH * m, w0, w1, w2, bb);
      }
      float sabs = 0.f;
#pragma unroll
      for (int m = 0; m < 32; ++m) { X[PADI(tid + NTH * m)] = {kv[m], m < 16 ? zreg[m & 15] : 0.f}; sabs += fabsf(kv[m]); }
      const float tot = block_sum(sabs, red, tid);
      const float inv = 1.f / tot;
      fft_fwd3(X, TW, tid);
#pragma unroll 2
      for (int m = 0; m < 4; ++m) {
        const int w = tid + NTH * m;
        const int gi = ((w >> 1) << 2) | (w & 1);
        const int g2 = (w == 0) ? 2 : rev6(4096 - rev6(gi));
        c32* pa = X + PADI(4 * gi); c32* pb = X + PADI(4 * g2);
        c32 A0 = pa[0], A1 = pa[1], A2 = pa[2], A3 = pa[3], B0 = pb[0], B1 = pb[1], B2 = pb[2], B3 = pb[3];
        fwd4(A0, A1, A2, A3, A0, A0, A0, false);
        fwd4(B0, B1, B2, B3, B0, B0, B0, false);
        if (w == 0) {
          A0 = {A0.x * A0.y * inv, 0.f}; A2 = {A2.x * A2.y * inv, 0.f}; pairprod(A1, A3, inv);
          pairprod(B0, B3, inv); pairprod(B1, B2, inv);
        } else { pairprod(A0, B3, inv); pairprod(A1, B2, inv); pairprod(A2, B1, inv); pairprod(A3, B0, inv); }
        inv4(A0, A1, A2, A3, A0, A0, A0, false);
        inv4(B0, B1, B2, B3, B0, B0, B0, false);
        pa[0] = A0; pa[1] = A1; pa[2] = A2; pa[3] = A3; pb[0] = B0; pb[1] = B1; pb[2] = B2; pb[3] = B3;
      }
      __syncthreads();
      fft_inv3(X, TW, tid);
      const float bias = hb[o * 1024 + ch];
      const int col = (o == 0 ? 0 : 1024) + ch;
      const bf16_t* pc = PT + (size_t)col * MR + CTX;
      const float w0 = cw[col], w1 = cw[3072 + col], w2 = cw[2 * 3072 + col], bb = cb[col];
      float xg[16], gt[16];
#pragma unroll
      for (int m = 0; m < 16; ++m) {
        const int t = tid + NTH * m;
        xg[m] = conv3_at(pc, t, w0, w1, w2, bb);
        gt[m] = o == 0 ? 0.f : bf2f(GTp[(size_t)ch * MR + CTX + t]);
      }
#pragma unroll
      for (int m = 0; m < 16; ++m) {
        const int t = tid + NTH * m;
        const float y = X[PADI(t)].x * (1.f / (float)FN);
        const float r = xg[m] * (y + bias * zreg[m]);
        if (o == 0) zreg[m] = r;
        else {
          const unsigned hv = (unsigned)f2bf(r * silu_f(gt[m]));
          if ((c & 1) == 0) outp[m] = hv;
          else *(unsigned*)(O + (size_t)(CTX + t) * D + 1024 + 4 * it + c - 1) = outp[m] | (hv << 16);
        }
      }
      __syncthreads();
    }
  }
}
DI void hyena_ctx_item(const Params& p, unsigned char* lds, int e, int it) {
  float* kk = (float*)lds;
  float* zz = kk + 1024;
  float* red = (float*)(lds + LDS_RED);
  const int tid = TIDX(), half = tid >> 8, t = tid & 255, ch = 2 * it + half;
  const bf16_t* P = (const bf16_t*)(p.ws + WS_P);
  bf16_t* O = (bf16_t*)(p.ws + WS_O);
  const float* cw = p.in[12] + (size_t)e * 3 * 3072; const float* cb = p.in[13] + (size_t)e * 3072;
  const float* hb = p.in[21] + (size_t)e * 2 * 1024;
  float u3[3];
#pragma unroll
  for (int q = 0; q < 3; ++q) {
    const int col = q * 1024 + ch;
    const bf16_t* pr = (const bf16_t*)(p.ws + WS_XT) + (size_t)col * MR;
    const float pm = t > 0 ? bf2f(pr[t - 1]) : 0.f;
    const float pc = bf2f(pr[t]);
    const float pp = t < CTX - 1 ? bf2f(pr[t + 1]) : 0.f;
    u3[q] = cw[col] * pm + cw[3072 + col] * pc + cw[2 * 3072 + col] * pp + cb[col];
  }
  float zin = u3[2];
  for (int o = 0; o < 2; ++o) {
    const float* tp = (const float*)(p.ws + WS_TAPS256) + (size_t)(o * 1024 + ch) * 512;
    const float k0 = tp[t], k1 = tp[t + 256];
    kk[half * 512 + t] = k0; kk[half * 512 + t + 256] = k1; zz[half * 256 + t] = zin;
    float sa = wave_sum(fabsf(k0) + fabsf(k1));
    __syncthreads();
    if ((tid & 63) == 0) red[tid >> 6] = sa;
    __syncthreads();
    const float tot = red[half * 4] + red[half * 4 + 1] + red[half * 4 + 2] + red[half * 4 + 3];
    float y0 = 0.f, y1 = 0.f, y2 = 0.f, y3 = 0.f;
    const float* kq = kk + half * 512; const float* zq = zz + half * 256;
#pragma unroll 4
    for (int s = 0; s < 256; s += 4) {
      const f32x4 z4 = *(const f32x4*)(zq + s);
      y0 += kq[(t - s) & 511] * z4[0]; y1 += kq[(t - s - 1) & 511] * z4[1]; y2 += kq[(t - s - 2) & 511] * z4[2]; y3 += kq[(t - s - 3) & 511] * z4[3];
    }
    float y = ((y0 + y1) + (y2 + y3)) / tot;
    const float bias = hb[o * 1024 + ch];
    if (o == 0) zin = u3[0] * (y + bias * zin);
    else {
      const float g = bf2f(((const bf16_t*)(p.ws + WS_YT))[(size_t)ch * MR + t]);
      O[(size_t)t * D + 1024 + ch] = f2bf(u3[1] * (y + bias * zin) * silu_f(g));
    }
    __syncthreads();
  }
}

template <int DK>
DI void attn_item(unsigned char* lds, const bf16_t* __restrict__ Qp, int ldq, const bf16_t* __restrict__ Kp, int ldk,
                  const bf16_t* __restrict__ Krp, int ldkr, const bf16_t* __restrict__ Vtp, const bf16_t* __restrict__ Qrp,
                  int qrow0, int r0n, int r1s, int r1n, bool window, bool has_sink, float sinkv, float sc,
                  const bf16_t* __restrict__ Gp, int ldg, bf16_t* __restrict__ Op, int ldo) {
  constexpr int KB = 64 * DK * 2, BUF = KB + 16384, NCH = DK / 8, NST = DK / 16;
  const int tid = TIDX(), lane = tid & 63, wave = tid >> 6, h = lane >> 5, l31 = lane & 31;
  const int qrow = qrow0 + wave * 32 + l31;
  bf16x8 qf[NST];
#pragma unroll
  for (int st = 0; st < NST; ++st) qf[st] = st < 8 ? *(const bf16x8*)(Qp + (size_t)qrow * ldq + 16 * st + 8 * h) : *(const bf16x8*)(Qrp + (size_t)qrow * ldq + 16 * (st - 8) + 8 * h);
  f32x16 oacc[4];
#pragma unroll
  for (int i = 0; i < 4; ++i)
#pragma unroll
    for (int r = 0; r < 16; ++r) oacc[i][r] = 0.f;
  float m_run = has_sink ? sinkv * LOG2E : -1e30f;
  float l_run = (has_sink && h == 0) ? 1.f : 0.f;
  const int nt = r0n + r1n;
  unsigned koff[NCH / 8], voff[2];
  bool kext[NCH / 8];
#pragma unroll
  for (int i = 0; i < NCH / 8; ++i) {
    const int id = tid + NTH * i, kr = id / NCH, ks = id % NCH;
    const int kc = DK == 128 ? (ks ^ (kr & 15)) : ((ks & ~7) | ((ks & 7) ^ (kr & 7)));
    kext[i] = kc >= 16;
    koff[i] = kc < 16 ? (unsigned)(kr * ldk + kc * 8) * 2u : (unsigned)(kr * ldkr + (kc - 16) * 8) * 2u;
  }
#pragma unroll
  for (int i = 0; i < 2; ++i) {
    const int vr = (tid >> 3) + 64 * i, vs = tid & 7;
    voff[i] = (unsigned)(vr * MR + (vs ^ ((vr >> 1) & 7)) * 8) * 2u;
  }
#define ATT_STAGE(ti, b) do { const int r0_ = (ti) < r0n ? 64 * (ti) : r1s + 64 * ((ti) - r0n); unsigned char* base_ = lds + (b) * BUF; \
    const char* kb_ = (const char*)Kp + (size_t)r0_ * ldk * 2; const char* kb2_ = (const char*)Krp + (size_t)r0_ * ldkr * 2; const char* vb_ = (const char*)Vtp + (size_t)r0_ * 2; \
    _Pragma("unroll") for (int i = 0; i < NCH / 8; ++i) __builtin_amdgcn_global_load_lds((const unsigned*)((kext[i] ? kb2_ : kb_) + koff[i]), (unsigned*)(base_ + (tid + NTH * i) * 16), 16, 0, 0); \
    _Pragma("unroll") for (int i = 0; i < 2; ++i) __builtin_amdgcn_global_load_lds((const unsigned*)(vb_ + voff[i]), (unsigned*)(base_ + KB + (tid + NTH * i) * 16), 16, 0, 0); } while (0)
  ATT_STAGE(0, 0);
  __syncthreads();
  for (int ti = 0; ti < nt; ++ti) {
    const unsigned char* cur = lds + (ti & 1) * BUF;
    const bool more = ti + 1 < nt;
    if (more) ATT_STAGE(ti + 1, (ti + 1) & 1);
    __builtin_amdgcn_sched_barrier(0);
    const int r0 = ti < r0n ? 64 * ti : r1s + 64 * (ti - r0n);
    f32x16 s0, s1;
#pragma unroll
    for (int r = 0; r < 16; ++r) { s0[r] = 0.f; s1[r] = 0.f; }
    {
      bf16x8 ka[2], kb[2];
      {
        const int co = (DK == 128 ? (h ^ (l31 & 15)) : ((h & ~7) | ((h & 7) ^ (l31 & 7)))) << 4;
        ka[0] = *(const bf16x8*)(cur + l31 * (DK * 2) + co); kb[0] = *(const bf16x8*)(cur + (32 + l31) * (DK * 2) + co);
      }
#pragma unroll
      for (int st = 0; st < NST; ++st) {
        if (st + 1 < NST) {
          const int c = 2 * (st + 1) + h;
          const int co = (DK == 128 ? (c ^ (l31 & 15)) : ((c & ~7) | ((c & 7) ^ (l31 & 7)))) << 4;
          ka[(st + 1) & 1] = *(const bf16x8*)(cur + l31 * (DK * 2) + co);
          kb[(st + 1) & 1] = *(const bf16x8*)(cur + (32 + l31) * (DK * 2) + co);
        }
        __builtin_amdgcn_sched_barrier(0);
        s0 = MFMA16(ka[st & 1], qf[st], s0);
        s1 = MFMA16(kb[st & 1], qf[st], s1);
        __builtin_amdgcn_sched_barrier(0);
      }
    }
    float mx = -INFINITY;
    if (window) {
#pragma unroll
      for (int r = 0; r < 16; ++r) {
        const int k0r = r0 + crow(r, h), k1r = k0r + 32;
        const int dq0 = (qrow - k0r), dq1 = (qrow - k1r);
        if (k0r >= CTX && (dq0 > 128 || dq0 < -128)) s0[r] = -INFINITY;
        if (k1r >= CTX && (dq1 > 128 || dq1 < -128)) s1[r] = -INFINITY;
      }
    }
#pragma unroll
    for (int r = 0; r < 16; ++r) mx = fmaxf(mx, fmaxf(s0[r], s1[r]));
    mx = fmaxf(mx, __shfl_xor(mx, 32));
    const float m_new = fmaxf(m_run, mx);
    if (__builtin_amdgcn_ballot_w64(m_new > m_run) != 0ull) {
      const float alpha = __builtin_amdgcn_exp2f(m_run - m_new);
      l_run *= alpha;
#pragma unroll
      for (int i = 0; i < 4; ++i)
#pragma unroll
        for (int r = 0; r < 16; ++r) oacc[i][r] *= alpha;
    }
    m_run = m_new;
    float ls = 0.f;
#pragma unroll
    for (int r = 0; r < 16; ++r) {
      const float p0 = __builtin_amdgcn_exp2f(s0[r] - m_new), p1 = __builtin_amdgcn_exp2f(s1[r] - m_new);
      s0[r] = p0; s1[r] = p1; ls += p0 + p1;
    }
    l_run += ls;
    bf16x8 pf[2][2];
#pragma unroll
    for (int s2 = 0; s2 < 2; ++s2) {
      u32x4 w0, w1;
#pragma unroll
      for (int q = 0; q < 4; ++q) { w0[q] = pk2(s0[8 * s2 + 2 * q], s0[8 * s2 + 2 * q + 1]); w1[q] = pk2(s1[8 * s2 + 2 * q], s1[8 * s2 + 2 * q + 1]); }
      pf[0][s2] = __builtin_bit_cast(bf16x8, w0); pf[1][s2] = __builtin_bit_cast(bf16x8, w1);
    }
    if (DK == 128) {
      bf16x8 va[2];
#define VFRAG(u_) [&]() { const int dvt_ = (u_) >> 2, c0_ = ((u_) & 3) * 2; const int vr_ = dvt_ * 32 + l31; const unsigned char* vb_ = cur + KB + vr_ * 128 + 8 * h; const int sw_ = (vr_ >> 1) & 7; \
        const s16x4 lo_ = *(const s16x4*)(vb_ + ((c0_ ^ sw_) << 4)); const s16x4 hi_ = *(const s16x4*)(vb_ + (((c0_ + 1) ^ sw_) << 4)); return (bf16x8)__builtin_shufflevector(lo_, hi_, 0, 1, 2, 3, 4, 5, 6, 7); }()
      va[0] = VFRAG(0);
#pragma unroll
      for (int u = 0; u < 16; ++u) {
        if (u + 1 < 16) va[(u + 1) & 1] = VFRAG(u + 1);
        __builtin_amdgcn_sched_barrier(0);
        oacc[u >> 2] = MFMA16(va[u & 1], pf[(u >> 1) & 1][u & 1], oacc[u >> 2]);
        __builtin_amdgcn_sched_barrier(0);
      }
#undef VFRAG
    } else {
#pragma unroll
    for (int dvt = 0; dvt < 4; ++dvt) {
      const int vr = dvt * 32 + l31;
      const unsigned char* vb = cur + KB + vr * 128 + 8 * h;
      const int sw = (vr >> 1) & 7;
#pragma unroll
      for (int sub = 0; sub < 2; ++sub)
#pragma unroll
        for (int s2 = 0; s2 < 2; ++s2) {
          const int c0 = sub * 4 + 2 * s2;
          const s16x4 lo = *(const s16x4*)(vb + ((c0 ^ sw) << 4));
          const s16x4 hi = *(const s16x4*)(vb + (((c0 + 1) ^ sw) << 4));
          const bf16x8 a = __builtin_shufflevector(lo, hi, 0, 1, 2, 3, 4, 5, 6, 7);
          oacc[dvt] = MFMA16(a, pf[sub][s2], oacc[dvt]);
        }
      __builtin_amdgcn_sched_barrier(0);
    }
    }
    __syncthreads();
  }
#undef ATT_STAGE
  const float l_tot = l_run + __shfl_xor(l_run, 32);
  const float inv = 1.f / l_tot;
#pragma unroll
  for (int dvt = 0; dvt < 4; ++dvt)
#pragma unroll
    for (int g = 0; g < 4; ++g) {
      const int dv = dvt * 32 + 8 * g + 4 * h;
      const u32x2 gw = *(const u32x2*)(Gp + (size_t)qrow * ldg + dv);
      const float g0 = __uint_as_float(gw[0] << 16), g1 = __uint_as_float(gw[0] & 0xffff0000u), g2 = __uint_as_float(gw[1] << 16), g3 = __uint_as_float(gw[1] & 0xffff0000u);
      u32x2 w;
      w[0] = pk2(oacc[dvt][4 * g] * inv * silu_f(g0), oacc[dvt][4 * g + 1] * inv * silu_f(g1));
      w[1] = pk2(oacc[dvt][4 * g + 2] * inv * silu_f(g2), oacc[dvt][4 * g + 3] * inv * silu_f(g3));
      *(u32x2*)(Op + (size_t)qrow * ldo + dv) = w;
    }
}

template <bool odd>
DI void attn_items_AC(const Params& p, unsigned char* lds, int layer, int item) {
  const int e = layer >> 1;
  const int ld = odd ? NPO : NPE; const int goff = odd ? 2368 : 4608;
  const bf16_t* P = (const bf16_t*)(p.ws + WS_P);
  bf16_t* O = (bf16_t*)(p.ws + WS_O);
  const int hd = item & 7, qb = item >> 3;
  const int kvh = hd >> 2;
  const bool isctx = qb == 32;
  const int qrow0 = isctx ? 0 : CTX + qb * 256;
  int r0n = 4, r1s = CTX, r1n = 0; bool window = false;
  if (!isctx) {
    if (odd) { r1s = CTX; r1n = SEQ / 64; }
    else { int s0 = qb * 256 - 128, s1 = qb * 256 + 256 + 128; if (s0 < 0) s0 = 0; if (s1 > SEQ) s1 = SEQ; r1s = CTX + s0; r1n = (s1 - s0) / 64; window = true; }
  }
  const bool has_sink = !odd;
  const float sinkv = has_sink ? p.in[11][e * 8 + hd] : 0.f;
  attn_item<128>(lds, P + hd * 128, ld, P + 1024 + kvh * 128, ld, nullptr, 0, (const bf16_t*)(p.ws + WS_VT) + (size_t)kvh * 128 * MR, nullptr,
                 qrow0, r0n, r1s, r1n, window, has_sink, sinkv, 0.08838834764831845f * LOG2E, P + goff + hd * 128, ld, O + hd * 128, D);
}
DI void attn_items_D(const Params& p, unsigned char* lds, int item) {
  const bf16_t* P = (const bf16_t*)(p.ws + WS_P);
  bf16_t* O = (bf16_t*)(p.ws + WS_O);
  const int hd = item & 7, qb = item >> 3;
  const bool isctx = qb == 32;
  const int qrow0 = isctx ? 0 : CTX + qb * 256;
  const int r1n = isctx ? 0 : SEQ / 64;
  attn_item<192>(lds, (const bf16_t*)(p.ws + WS_QM) + hd * 128, 1536, (const bf16_t*)(p.ws + WS_KV) + hd * 256, 2048, P + 2304, NPO,
                 (const bf16_t*)(p.ws + WS_VMT) + (size_t)hd * 128 * MR, (const bf16_t*)(p.ws + WS_QM) + 1024 + hd * 64, qrow0, 4, CTX, r1n, false, false, 0.f, 0.07216878364870322f * LOG2E,
                 P + 2368 + 1024 + hd * 128, NPO, O + 1024 + hd * 128, D);
}

template <bool odd>
DI void layer_body(unsigned char* lds, int layer) {
  const int e = layer >> 1;
  phase_norm(PP, layer);
  grid_barrier((unsigned*)(PP.ws + WS_BAR), (volatile unsigned*)(lds + LDS_RED + 128), TIDX());
  {
    EpiIn ep{(bf16_t*)(PP.ws + WS_P), odd ? NPO : NPE, odd ? NVO : NPE, (bf16_t*)(PP.ws + WS_VT), (bf16_t*)(PP.ws + WS_XT), odd ? 0 : 1536, odd ? 0 : 4608, (bf16_t*)(PP.ws + WS_YT), odd ? (1 << 30) : 5632};
    const bf16_t* W = odd ? (const bf16_t*)(PP.ws + WS_WTIN_O) + (size_t)e * NPO * D : (const bf16_t*)(PP.ws + WS_WTIN_E) + (size_t)e * NPE * D;
    const Params& q_ = PP;
    const TileFuse tfi{odd ? 1 : 0, e};
    gemm_phase(lds, W, D, (const bf16_t*)(PP.ws + WS_U), D, odd ? NPO : NPE, MR, D, 0, ep, 1, &tfi);
    if (layer < 2) { const int nt_ = odd ? 33 * 18 : 33 * 26; phase_taps(PP, layer, nt_ % (int)gridDim.x); }
  }
  grid_barrier((unsigned*)(PP.ws + WS_BAR), (volatile unsigned*)(lds + LDS_RED + 128), TIDX());
  if (odd) {
    {
      const Params& q2 = PP;
      EpiUQ eq{(bf16_t*)(q2.ws + WS_QM)};
      const TileFuse tfq{2, e};
      gemm_phase(lds, (const bf16_t*)(q2.ws + WS_WTUQ) + (size_t)e * 1536 * 512, 512, (const bf16_t*)(q2.ws + WS_P) + 1536, NPO, 1536, MR, 512, 0, eq, 1, &tfq);
      EpiUKV ek{(bf16_t*)(q2.ws + WS_KV), (bf16_t*)(q2.ws + WS_VMT)};
      const TileFuse tfk{3, e};
      gemm_phase(lds, (const bf16_t*)(q2.ws + WS_WTUKV) + (size_t)e * 2048 * 256, 256, (const bf16_t*)(q2.ws + WS_P) + 2048, NPO, 2048, MR, 256, 0, ek, 1, &tfk);
    }
    grid_barrier((unsigned*)(PP.ws + WS_BAR), (volatile unsigned*)(lds + LDS_RED + 128), TIDX());
    for (int rep = 0; rep < (PROBE == 1 ? 2 : 1); ++rep)
    for (int it = vblock(); it < 528; it += gridDim.x) {
      if (it < 256) attn_items_AC<true>(PP, lds, layer, it);
      else if (it < 512) attn_items_D(PP, lds, it - 256);
      else if (it < 520) attn_items_AC<true>(PP, lds, layer, 256 + (it - 512));
      else attn_items_D(PP, lds, 256 + (it - 520));
    }
    grid_barrier((unsigned*)(PP.ws + WS_BAR), (volatile unsigned*)(lds + LDS_RED + 128), TIDX());
  } else {
    {
      const c32* TWg = (const c32*)(PP.ws + WS_TW); c32* wt = (c32*)(lds + LDS_WT); const int t_ = TIDX();
      for (int j = t_; j < 1024; j += NTH) wt[j] = TWg[j];
      if (t_ < 64) wt[1024 + t_] = TWg[t_ << 4];
      if (t_ < 4) wt[1088 + t_] = TWg[t_ << 8];
      __syncthreads();
    }
    for (int rep = 0; rep < (PROBE == 3 ? 2 : 1); ++rep)
    for (int it = vblock(); it < 256 + 264 + 512; it += gridDim.x) {
      if (it < 256) hyena_item(PP, lds, e, it);
      else if (it < 256 + 264) attn_items_AC<false>(PP, lds, layer, it - 256);
      else hyena_ctx_item(PP, lds, e, it - 520);
    }
    grid_barrier((unsigned*)(PP.ws + WS_BAR), (volatile unsigned*)(lds + LDS_RED + 128), TIDX());
  }
  {
    const Params& q = PP; EpiOut eo{(float*)(q.ws + WS_H), q.out, (const float*)(q.ws + WS_MODS), layer};
    gemm_phase(lds, (const bf16_t*)(PP.ws + WS_WTOUT) + (size_t)layer * D * D, D, (const bf16_t*)(PP.ws + WS_O), D, D, MR, D, 1, eo);
    if (layer < 3) {
      EpiOutPart ea{(float*)(q.ws + WS_PART)};
      gemm_phase(lds, (const bf16_t*)(PP.ws + WS_WTOUT) + (size_t)layer * D * D, D, (const bf16_t*)(PP.ws + WS_O), D, D, 256, D, 0, ea, 8);
    }
  }
}
__global__ void __launch_bounds__(NTH) fwd_megakernel(Params p_unused) {
  extern __shared__ __attribute__((aligned(16))) unsigned char lds[];
  cg::grid_group grid = cg::this_grid();
  {
    volatile unsigned* st = (volatile unsigned*)(lds + LDS_RED + 128);
    unsigned* bar0 = (unsigned*)(PP.ws + WS_BAR);
    if (TIDX() == 0) { st[0] = 0u; st[1] = 0u; (void)xb_add(&bar0[XB_XCNT(xb_xcc_id())], 1u); }
    __syncthreads();
  }
  phase_prep(PP, lds);
  grid.sync();
  for (int l2 = 0; l2 < 2; ++l2) {
    layer_body<false>(lds, 2 * l2);
    grid_barrier((unsigned*)(PP.ws + WS_BAR), (volatile unsigned*)(lds + LDS_RED + 128), TIDX());
    layer_body<true>(lds, 2 * l2 + 1);
    if (l2 == 0) grid_barrier((unsigned*)(PP.ws + WS_BAR), (volatile unsigned*)(lds + LDS_RED + 128), TIDX());
  }
}

extern "C" void kernel_launch(void* const* d_in, const int* in_sizes, int n_in, void* d_out, int out_size, void* d_ws, size_t ws_size, hipStream_t stream) {
  static int grid_blocks = 0;
  if (grid_blocks == 0) {
    if (n_in != 31 || ws_size < WS_END) { fprintf(stderr, "kernel_launch: bad inputs n_in=%d ws=%zu need=%zu\n", n_in, ws_size, (size_t)WS_END); grid_blocks = -1; return; }
    int dev = 0, cus = 0, per_cu = 0;
    (void)hipGetDevice(&dev);
    (void)hipDeviceGetAttribute(&cus, hipDeviceAttributeMultiprocessorCount, dev);
    if (hipFuncSetAttribute((const void*)fwd_megakernel, hipFuncAttributeMaxDynamicSharedMemorySize, LDS_BYTES) != hipSuccess) { fprintf(stderr, "kernel_launch: hipFuncSetAttribute failed\n"); grid_blocks = -1; return; }
    if (hipOccupancyMaxActiveBlocksPerMultiprocessor(&per_cu, (const void*)fwd_megakernel, NTH, LDS_BYTES) != hipSuccess || per_cu < 1) { fprintf(stderr, "kernel_launch: occupancy query failed (%d)\n", per_cu); per_cu = 1; }
    (void)hipGetLastError();
    grid_blocks = cus * per_cu;
  }
  if (grid_blocks < 0) return;
  (void)hipMemsetAsync((unsigned char*)d_ws + WS_MODS, 0, WS_TW - WS_MODS, stream);
  Params p{};
  for (int i = 0; i < 31; ++i) p.in[i] = (const float*)d_in[i];
  p.out = (float*)d_out; p.ws = (unsigned char*)d_ws;
  void* args[] = {&p};
  hipError_t er = hipLaunchCooperativeKernel((const void*)fwd_megakernel, dim3(grid_blocks), dim3(NTH), args, LDS_BYTES, stream);
  if (er != hipSuccess) fprintf(stderr, "cooperative launch failed: %s (grid %d)\n", hipGetErrorString(er), grid_blocks);
}
```

```cpp
#include <hip/hip_runtime.h>
#include <hip/hip_cooperative_groups.h>
#include <cstdio>
namespace cg = cooperative_groups;

#define DI __device__ __forceinline__
#ifndef PROBE
#define PROBE 0
#endif
typedef unsigned short bf16_t;
using bf16x8 = __attribute__((ext_vector_type(8))) short;
using s16x4 = __attribute__((ext_vector_type(4))) short;
using f32x16 = __attribute__((ext_vector_type(16))) float;
using f32x4 = __attribute__((ext_vector_type(4))) float;
using u32x4 = __attribute__((ext_vector_type(4))) unsigned;
using u32x2 = __attribute__((ext_vector_type(2))) unsigned;

constexpr int D = 2048, SEQ = 8192, CTX = 256, MR = SEQ + CTX;
constexpr int NPE = 6656, NPO = 4608, NVO = 4416;
constexpr int FN = 16384;
constexpr int XCD_BAR_WORDS_C = 3456;
constexpr int NTH = 512;
constexpr float EPS = 1e-6f;
constexpr float LOG2E = 1.4426950408889634f;
constexpr float QSCALE128 = 0.08838834764831845f * LOG2E, QSCALE192 = 0.07216878364870322f * LOG2E;
constexpr float DECAY_MAX = 15.350567286626973f, DECAY_MIN = 3.0701134573253945f;

constexpr size_t AL(size_t x) { return (x + 255) & ~(size_t)255; }
constexpr size_t WS_WTIN_E = 0;
constexpr size_t WS_WTIN_O = WS_WTIN_E + AL((size_t)2 * NPE * D * 2);
constexpr size_t WS_WTOUT = WS_WTIN_O + AL((size_t)2 * NPO * D * 2);
constexpr size_t WS_WTUQ = WS_WTOUT + AL((size_t)4 * D * D * 2);
constexpr size_t WS_WTUKV = WS_WTUQ + AL((size_t)2 * 1536 * 512 * 2);
constexpr size_t WS_MODS = WS_WTUKV + AL((size_t)2 * 2048 * 256 * 2);
constexpr size_t WS_BAR = WS_MODS + AL((size_t)4 * 2 * 6144 * 4);
constexpr size_t WS_ROWSQ = WS_BAR + AL((size_t)XCD_BAR_WORDS_C * 4);
constexpr size_t WS_TW = WS_ROWSQ + AL((size_t)2 * 2 * MR * 4);
constexpr size_t WS_ROPE = WS_TW + AL((size_t)FN * 8);
constexpr size_t WS_ROPE64 = WS_ROPE + AL((size_t)2 * SEQ * 64 * 4);
constexpr size_t WS_HID = WS_ROPE64 + AL((size_t)2 * SEQ * 32 * 4);
constexpr size_t WS_HID256 = WS_HID + AL((size_t)2 * SEQ * 64 * 4);
constexpr size_t WS_H = WS_HID256 + AL((size_t)2 * CTX * 64 * 4);
constexpr size_t WS_U = WS_H + AL((size_t)MR * D * 4);
constexpr size_t WS_P = WS_U + AL((size_t)MR * D * 2);
constexpr size_t WS_VT = WS_P + AL((size_t)MR * NPE * 2);
constexpr size_t WS_O = WS_VT + AL((size_t)2 * 128 * MR * 2);
constexpr size_t WS_TAPS = WS_O + AL((size_t)MR * D * 2);
constexpr size_t WS_TAPS256 = WS_TAPS + AL((size_t)2 * 1024 * FN * 4);
constexpr size_t WS_YT = WS_TAPS256 + AL((size_t)2 * 1024 * 512 * 4);
constexpr size_t WS_XT = WS_YT + AL((size_t)1024 * SEQ * 4);
constexpr size_t WS_QM = WS_XT;
constexpr size_t WS_KV = WS_QM + AL((size_t)MR * 1536 * 2);
constexpr size_t WS_VMT = WS_KV + AL((size_t)MR * 2048 * 2);
constexpr size_t WS_END_ODD = WS_VMT + AL((size_t)8 * 128 * MR * 2);
constexpr size_t WS_END_EVEN = WS_XT + AL((size_t)3072 * SEQ * 4);
constexpr size_t WS_KZ = WS_END_ODD > WS_END_EVEN ? WS_END_ODD : WS_END_EVEN;
constexpr size_t WS_PART = WS_KZ;
constexpr size_t WS_END = WS_KZ + (size_t)256 * FN * 8;

constexpr int LDS_MAIN = 139264, LDS_WT = LDS_MAIN, LDS_RED = LDS_WT + 8960, LDS_BYTES = LDS_RED + 256;

struct Params { const float* in[31]; float* out; unsigned char* ws; };

typedef __attribute__((ext_vector_type(2))) __bf16 bf16x2_t;
typedef __attribute__((ext_vector_type(2))) float f32x2;
DI bf16_t f2bf(float x) { return __builtin_bit_cast(unsigned short, (__bf16)x); }
DI float bf2f(bf16_t h) { return __uint_as_float(((unsigned)h) << 16); }
DI unsigned pk2(float a, float b) { return __builtin_bit_cast(unsigned, __builtin_convertvector((f32x2){a, b}, bf16x2_t)); }
DI int TIDX() { int t = threadIdx.x; asm volatile("" : "+v"(t)); return t; }
#define XB_TMO      128
#define XB_XCNT(j)  (256  + 64 * (j))
#define XB_XSUB(j)  (1280 + 64 * (j))
#define XB_XGEN(j)  (2304 + 64 * (j))
#define XB_TOP      3328
#define XB_TOPGEN   3392
#define XB_SPIN_CAP (1u << 18)
DI unsigned xb_ld(unsigned* p) { return __hip_atomic_load(p, __ATOMIC_RELAXED, __HIP_MEMORY_SCOPE_AGENT); }
DI unsigned xb_add(unsigned* p, unsigned v) { return __hip_atomic_fetch_add(p, v, __ATOMIC_RELAXED, __HIP_MEMORY_SCOPE_AGENT); }
DI unsigned xb_xcc_id() { return (unsigned)__builtin_amdgcn_s_getreg((3 << 11) | 20) & 0xFu; }
#define XB_SPIN(cond, bar) do { unsigned _sp = 0; while (cond) { __builtin_amdgcn_s_sleep(1); \
    if ((++_sp & 255u) == 0u) { if (xb_ld(&(bar)[XB_TMO])) break; if (_sp > XB_SPIN_CAP) { atomicAdd(&(bar)[XB_TMO], 1u); break; } } } } while (0)
DI void xcd_barrier_complete(unsigned* bar, unsigned x, unsigned& nloc, unsigned& nx) {
  const unsigned G = gridDim.x;
  unsigned sum, cnt, mine, sp = 0u;
  for (;;) {
    sum = 0u; cnt = 0u; mine = 0u;
#pragma unroll
    for (unsigned j = 0; j < 16; ++j) { const unsigned c = xb_ld(&bar[XB_XCNT(j)]); sum += c; cnt += (c > 0u) ? 1u : 0u; mine = (j == x) ? c : mine; }
    if (sum == G) break;
    __builtin_amdgcn_s_sleep(1);
    if ((++sp & 255u) == 0u) { if (xb_ld(&bar[XB_TMO])) break; if (sp > XB_SPIN_CAP) { atomicAdd(&bar[XB_TMO], 1u); break; } }
  }
  nloc = mine > 0u ? mine : 1u; nx = cnt > 0u ? cnt : 1u;
}
DI void grid_barrier(unsigned* bar, volatile unsigned* st, int tid) {
  asm volatile("s_waitcnt vmcnt(0)" ::: "memory");
  __syncthreads();
  if (tid == 0) {
    __builtin_amdgcn_s_waitcnt(0);
    const unsigned x = xb_xcc_id();
    unsigned nloc = st[0], nx = st[1];
    if (nloc == 0u) { xcd_barrier_complete(bar, x, nloc, nx); st[0] = nloc; st[1] = nx; }
    const unsigned old = xb_add(&bar[XB_XSUB(x)], 1u);
    const unsigned gen = old / nloc;
    if (old + 1u == (gen + 1u) * nloc) {
      __builtin_amdgcn_fence(__ATOMIC_RELEASE, "agent");
      asm volatile("s_waitcnt vmcnt(0)" ::: "memory");
      const unsigned og = xb_add(&bar[XB_TOP], 1u);
      const unsigned tg = og / nx;
      if (og + 1u == (tg + 1u) * nx) xb_add(&bar[XB_TOPGEN], 1u);
      else XB_SPIN(xb_ld(&bar[XB_TOPGEN]) == tg, bar);
      __builtin_amdgcn_fence(__ATOMIC_ACQUIRE, "agent");
      xb_add(&bar[XB_XGEN(x)], 1u);
      asm volatile("s_waitcnt vmcnt(0)" ::: "memory");
    } else {
      XB_SPIN(xb_ld(&bar[XB_XGEN(x)]) == gen, bar);
      __builtin_amdgcn_fence(__ATOMIC_ACQUIRE, "agent");
      asm volatile("s_waitcnt vmcnt(0)" ::: "memory");
    }
  }
  __syncthreads();
}
DI int vblock() { const int b = blockIdx.x, G = gridDim.x; return (G % 8 == 0) ? (b % 8) * (G / 8) + b / 8 : b; }
DI float wave_sum(float v) {
#pragma unroll
  for (int o = 32; o > 0; o >>= 1) v += __shfl_xor(v, o);
  return v;
}
DI float silu_f(float x) { return x / (1.f + expf(-x)); }
DI int crow(int reg, int h) { return (reg & 3) + 8 * (reg >> 2) + 4 * h; }
#define MFMA16(a, b, c) __builtin_amdgcn_mfma_f32_32x32x16_bf16((a), (b), (c), 0, 0, 0)

struct c32 { float x, y; };
DI c32 cmul(c32 a, c32 b) { c32 r; r.x = a.x * b.x - a.y * b.y; r.y = a.x * b.y + a.y * b.x; return r; }
DI c32 cmulc(c32 a, c32 b) { c32 r; r.x = a.x * b.x + a.y * b.y; r.y = a.y * b.x - a.x * b.y; return r; }

DI int PADI(int p) { return p + (p >> 4); }
DI void fwd4(c32& a, c32& b, c32& c, c32& d, c32 w1, c32 w2, c32 w3, bool tw) {
  c32 t0 = {a.x + c.x, a.y + c.y}, t1 = {a.x - c.x, a.y - c.y};
  c32 t2 = {b.x + d.x, b.y + d.y};
  c32 bd = {b.x - d.x, b.y - d.y};
  c32 t3 = {bd.y, -bd.x};
  c32 y0 = {t0.x + t2.x, t0.y + t2.y};
  c32 y1 = {t1.x + t3.x, t1.y + t3.y};
  c32 y2 = {t0.x - t2.x, t0.y - t2.y};
  c32 y3 = {t1.x - t3.x, t1.y - t3.y};
  if (tw) { y1 = cmul(y1, w1); y2 = cmul(y2, w2); y3 = cmul(y3, w3); }
  a = y0; b = y1; c = y2; d = y3;
}
DI void inv4(c32& a, c32& b, c32& c, c32& d, c32 w1, c32 w2, c32 w3, bool tw) {
  if (tw) { b = cmulc(b, w1); c = cmulc(c, w2); d = cmulc(d, w3); }
  c32 t0 = {a.x + c.x, a.y + c.y}, t1 = {a.x - c.x, a.y - c.y};
  c32 t2 = {b.x + d.x, b.y + d.y};
  c32 bd = {b.x - d.x, b.y - d.y};
  c32 t3 = {-bd.y, bd.x};
  a = {t0.x + t2.x, t0.y + t2.y};
  b = {t1.x + t3.x, t1.y + t3.y};
  c = {t0.x - t2.x, t0.y - t2.y};
  d = {t1.x - t3.x, t1.y - t3.y};
}
DI c32 r16_cb(int b) {
  return b == 0 ? c32{1.f, 0.f} : b == 1 ? c32{0.9238795325112867f, -0.3826834323650898f} : b == 2 ? c32{0.7071067811865476f, -0.7071067811865476f} : c32{0.3826834323650898f, -0.9238795325112867f};
}
template <int S>
DI void fft_fwd_r16(c32* X, const c32* WT, int idx) {
  constexpr int lsp2 = 12 - 2 * (S + 1), sp2 = 1 << lsp2, sp1 = 4 * sp2;
  const int jp = idx & (sp2 - 1), base = ((idx >> lsp2) << (lsp2 + 4)) + jp;
  c32* Xb = X + PADI(base);
  c32 e[4][4];
#pragma unroll
  for (int a = 0; a < 4; ++a)
#pragma unroll
    for (int b = 0; b < 4; ++b) e[a][b] = Xb[a * (sp1 + sp1 / 16) + b * (sp2 + sp2 / 16)];
  const c32 W0 = WT[jp];
#pragma unroll
  for (int b = 0; b < 4; ++b) {
    const c32 w1 = b == 0 ? W0 : cmul(W0, r16_cb(b)), w2 = cmul(w1, w1), w3 = cmul(w2, w1);
    fwd4(e[0][b], e[1][b], e[2][b], e[3][b], w1, w2, w3, true);
  }
  {
    const c32 q2 = cmul(W0, W0), v1 = cmul(q2, q2), v2 = cmul(v1, v1), v3 = cmul(v2, v1);
#pragma unroll
    for (int a = 0; a < 4; ++a) fwd4(e[a][0], e[a][1], e[a][2], e[a][3], v1, v2, v3, true);
  }
#pragma unroll
  for (int a = 0; a < 4; ++a)
#pragma unroll
    for (int b = 0; b < 4; ++b) Xb[a * (sp1 + sp1 / 16) + b * (sp2 + sp2 / 16)] = e[a][b];
}
template <int S>
DI void fft_inv_r16(c32* X, const c32* WT, int idx) {
  constexpr int lsp2 = 12 - 2 * (S + 1), sp2 = 1 << lsp2, sp1 = 4 * sp2;
  const int jp = idx & (sp2 - 1), base = ((idx >> lsp2) << (lsp2 + 4)) + jp;
  c32* Xb = X + PADI(base);
  c32 e[4][4];
#pragma unroll
  for (int a = 0; a < 4; ++a)
#pragma unroll
    for (int b = 0; b < 4; ++b) e[a][b] = Xb[a * (sp1 + sp1 / 16) + b * (sp2 + sp2 / 16)];
  const c32 W0 = WT[jp];
  {
    const c32 q2 = cmul(W0, W0), v1 = cmul(q2, q2), v2 = cmul(v1, v1), v3 = cmul(v2, v1);
#pragma unroll
    for (int a = 0; a < 4; ++a) inv4(e[a][0], e[a][1], e[a][2], e[a][3], v1, v2, v3, true);
  }
#pragma unroll
  for (int b = 0; b < 4; ++b) {
    const c32 w1 = b == 0 ? W0 : cmul(W0, r16_cb(b)), w2 = cmul(w1, w1), w3 = cmul(w2, w1);
    inv4(e[0][b], e[1][b], e[2][b], e[3][b], w1, w2, w3, true);
  }
#pragma unroll
  for (int a = 0; a < 4; ++a)
#pragma unroll
    for (int b = 0; b < 4; ++b) Xb[a * (sp1 + sp1 / 16) + b * (sp2 + sp2 / 16)] = e[a][b];
}
DI void fft_fwd_last(c32* X, int idx) {
  const int p = 4 * idx, q = PADI(p);
  c32 a = X[q], b = X[q + 1], c = X[q + 2], d = X[q + 3];
  fwd4(a, b, c, d, a, a, a, false);
  X[q] = a; X[q + 1] = b; X[q + 2] = c; X[q + 3] = d;
}
DI void fft_inv_last(c32* X, int idx) {
  const int p = 4 * idx, q = PADI(p);
  c32 a = X[q], b = X[q + 1], c = X[q + 2], d = X[q + 3];
  inv4(a, b, c, d, a, a, a, false);
  X[q] = a; X[q + 1] = b; X[q + 2] = c; X[q + 3] = d;
}

DI void fft_fwd(c32* X, const c32* TW, int tid) {
  asm volatile("" : "+v"(tid));
  _Pragma("unroll 1") for (int r = 0; r < 2; ++r) fft_fwd_r16<0>(X, TW, tid + NTH * r);
  __syncthreads();
  asm volatile("" : "+v"(tid));
  _Pragma("unroll 1") for (int r = 0; r < 2; ++r) fft_fwd_r16<2>(X, TW + 1024, tid + NTH * r);
  __syncthreads();
  asm volatile("" : "+v"(tid));
  _Pragma("unroll 1") for (int r = 0; r < 2; ++r) fft_fwd_r16<4>(X, TW + 1088, tid + NTH * r);
  __syncthreads();
asm volatile("" : "+v"(tid));
#pragma unroll 4
  for (int b = 0; b < 8; ++b) fft_fwd_last(X, tid + NTH * b);
  __syncthreads();
}
DI void fft_fwd3(c32* X, const c32* TW, int tid) {
  asm volatile("" : "+v"(tid));
  _Pragma("unroll 1") for (int r = 0; r < 2; ++r) fft_fwd_r16<0>(X, TW, tid + NTH * r);
  __syncthreads();
  asm volatile("" : "+v"(tid));
  _Pragma("unroll 1") for (int r = 0; r < 2; ++r) fft_fwd_r16<2>(X, TW + 1024, tid + NTH * r);
  __syncthreads();
  asm volatile("" : "+v"(tid));
  _Pragma("unroll 1") for (int r = 0; r < 2; ++r) fft_fwd_r16<4>(X, TW + 1088, tid + NTH * r);
  __syncthreads();
}
DI void fft_inv3(c32* X, const c32* TW, int tid) {
  asm volatile("" : "+v"(tid));
  _Pragma("unroll 1") for (int r = 0; r < 2; ++r) fft_inv_r16<4>(X, TW + 1088, tid + NTH * r);
  __syncthreads();
  asm volatile("" : "+v"(tid));
  _Pragma("unroll 1") for (int r = 0; r < 2; ++r) fft_inv_r16<2>(X, TW + 1024, tid + NTH * r);
  __syncthreads();
  asm volatile("" : "+v"(tid));
  _Pragma("unroll 1") for (int r = 0; r < 2; ++r) fft_inv_r16<0>(X, TW, tid + NTH * r);
  __syncthreads();
}
DI int rev6(int x) { const unsigned r = __brev((unsigned)x) >> 20; return (int)(((r & 0xAAAu) >> 1) | ((r & 0x555u) << 1)); }
DI void pairprod(c32& a, c32& b, float inv) {
  const c32 K = {0.5f * (a.x + b.x), 0.5f * (a.y - b.y)};
  const c32 U = {0.5f * (a.y + b.y), -0.5f * (a.x - b.x)};
  c32 Y = cmul(K, U); Y.x *= inv; Y.y *= inv;
  a = Y; b = {Y.x, -Y.y};
}
DI void fft_inv(c32* X, const c32* TW, int tid) {
asm volatile("" : "+v"(tid));
#pragma unroll 4
  for (int b = 0; b < 8; ++b) fft_inv_last(X, tid + NTH * b);
  __syncthreads();
  asm volatile("" : "+v"(tid));
  _Pragma("unroll 1") for (int r = 0; r < 2; ++r) fft_inv_r16<4>(X, TW + 1088, tid + NTH * r);
  __syncthreads();
  asm volatile("" : "+v"(tid));
  _Pragma("unroll 1") for (int r = 0; r < 2; ++r) fft_inv_r16<2>(X, TW + 1024, tid + NTH * r);
  __syncthreads();
  asm volatile("" : "+v"(tid));
  _Pragma("unroll 1") for (int r = 0; r < 2; ++r) fft_inv_r16<0>(X, TW, tid + NTH * r);
  __syncthreads();
}

DI int perm_uq(int n) { const int hd = n / 192, d = n % 192; return d < 128 ? hd * 128 + d : 1024 + hd * 64 + (d - 128); }
DI void transpose_tile(float* tl, const float* __restrict__ src, bf16_t* __restrict__ dst, int K, int N, int t, int lane, const float* ks = nullptr, bool permq = false) {
  const int ntn = N >> 6;
  const int k0 = (t / ntn) << 6, n0 = (t % ntn) << 6;
  f32x4 v[16];
#pragma unroll
  for (int i = 0; i < 16; ++i) v[i] = *(const f32x4*)(src + (size_t)(k0 + 4 * i + (lane >> 4)) * N + n0 + 4 * (lane & 15));
#pragma unroll
  for (int i = 0; i < 16; ++i) {
    float* q = tl + (4 * i + (lane >> 4)) * 65 + 4 * (lane & 15);
    q[0] = v[i][0]; q[1] = v[i][1]; q[2] = v[i][2]; q[3] = v[i][3];
  }
  __builtin_amdgcn_fence(__ATOMIC_RELEASE, "wavefront");
  __builtin_amdgcn_wave_barrier();
  __builtin_amdgcn_fence(__ATOMIC_ACQUIRE, "wavefront");
#pragma unroll
  for (int i = 0; i < 8; ++i) {
    const int idx = lane + 64 * i, nn = idx >> 3, k8 = (idx & 7) * 8;
    float sc8[8];
#pragma unroll
    for (int q = 0; q < 8; ++q) sc8[q] = ks ? ks[k0 + k8 + q] : 1.f;
    u32x4 o;
    o[0] = pk2(tl[(k8 + 0) * 65 + nn] * sc8[0], tl[(k8 + 1) * 65 + nn] * sc8[1]);
    o[1] = pk2(tl[(k8 + 2) * 65 + nn] * sc8[2], tl[(k8 + 3) * 65 + nn] * sc8[3]);
    o[2] = pk2(tl[(k8 + 4) * 65 + nn] * sc8[4], tl[(k8 + 5) * 65 + nn] * sc8[5]);
    o[3] = pk2(tl[(k8 + 6) * 65 + nn] * sc8[6], tl[(k8 + 7) * 65 + nn] * sc8[7]);
    const int nrow = permq ? perm_uq(n0 + nn) : n0 + nn;
    *(u32x4*)(dst + (size_t)nrow * K + k0 + k8) = o;
  }
  __builtin_amdgcn_fence(__ATOMIC_RELEASE, "wavefront");
  __builtin_amdgcn_wave_barrier();
  __builtin_amdgcn_fence(__ATOMIC_ACQUIRE, "wavefront");
}
DI void transpose_mat(float* tl, const float* src, bf16_t* dst, int K, int N, int gw, int ngw, int lane, const float* ks = nullptr, bool permq = false) {
  const int nt = (K >> 6) * (N >> 6);
  for (int t = gw; t < nt; t += ngw) transpose_tile(tl, src, dst, K, N, t, lane, ks, permq);
}

DI void phase_prep(const Params& p, unsigned char* lds) {
  unsigned char* ws = p.ws;
  const int tid = TIDX(), lane = tid & 63, wave = tid >> 6;
  float* tl = (float*)lds + wave * (64 * 65);
  const int gw_t = blockIdx.x * 8 + wave, ngw_t = gridDim.x * 8;
  for (int e = 0; e < 2; ++e) {
    transpose_mat(tl, p.in[8] + (size_t)e * D * NPE, (bf16_t*)(ws + WS_WTIN_E) + (size_t)e * NPE * D, D, NPE, gw_t, ngw_t, lane);
    transpose_mat(tl, p.in[22] + (size_t)e * D * NVO, (bf16_t*)(ws + WS_WTIN_O) + (size_t)e * NPO * D, D, NVO, gw_t, ngw_t, lane);
    transpose_mat(tl, p.in[27] + (size_t)e * 512 * 1536, (bf16_t*)(ws + WS_WTUQ) + (size_t)e * 1536 * 512, 512, 1536, gw_t, ngw_t, lane, p.in[25] + e * 512, true);
    transpose_mat(tl, p.in[28] + (size_t)e * 256 * 2048, (bf16_t*)(ws + WS_WTUKV) + (size_t)e * 2048 * 256, 256, 2048, gw_t, ngw_t, lane, p.in[26] + e * 256, false);
    bf16_t* zp = (bf16_t*)(ws + WS_WTIN_O) + (size_t)e * NPO * D + (size_t)NVO * D;
    for (int i = blockIdx.x * NTH + tid; i < (NPO - NVO) * D / 8; i += gridDim.x * NTH) ((u32x4*)zp)[i] = (u32x4){0u, 0u, 0u, 0u};
  }
  for (int i = 0; i < 4; ++i) transpose_mat(tl, p.in[7] + (size_t)i * D * D, (bf16_t*)(ws + WS_WTOUT) + (size_t)i * D * D, D, D, gw_t, ngw_t, lane);
  {
    const float* cv = p.in[1]; const float* cc = p.in[3]; const float* aw = p.in[4]; const float* ab = p.in[5];
    float* mods = (float*)(ws + WS_MODS);
    for (int u = blockIdx.x; u < 4 * 64 * 3; u += gridDim.x) {
      const int i = u / 192, rem = u % 192, kc = rem / 3, nb = rem % 3;
      const int n = nb * 2048 + tid * 4;
      f32x4 al = {0.f, 0.f, 0.f, 0.f}, ac = {0.f, 0.f, 0.f, 0.f};
#pragma unroll
      for (int k8 = 0; k8 < 32; k8 += 8) {
        f32x4 w[8];
#pragma unroll
        for (int q = 0; q < 8; ++q) w[q] = *(const f32x4*)(aw + ((size_t)i * D + kc * 32 + k8 + q) * 6144 + n);
#pragma unroll
        for (int q = 0; q < 8; ++q) { const int k = kc * 32 + k8 + q; const float a = silu_f(cv[k]), b = silu_f(cc[k]); al += a * w[q]; ac += b * w[q]; }
      }
      if (kc == 0) { const f32x4 bb = *(const f32x4*)(ab + i * 6144 + n); al += bb; ac += bb; }
#pragma unroll
      for (int j = 0; j < 4; ++j) { atomicAdd(&mods[(i * 2 + 0) * 6144 + n + j], al[j]); atomicAdd(&mods[(i * 2 + 1) * 6144 + n + j], ac[j]); }
    }
  }
  {
    c32* TW = (c32*)(ws + WS_TW);
    for (int m = blockIdx.x * NTH + tid; m < FN; m += gridDim.x * NTH) {
      float sn, cs; sincospif(2.f * (float)m / (float)FN, &sn, &cs);
      TW[m] = {cs, -sn};
    }
  }
  {
    float* ct = (float*)(ws + WS_ROPE); float* st = ct + (size_t)SEQ * 64;
    for (int i = blockIdx.x * NTH + tid; i < SEQ * 64; i += gridDim.x * NTH) {
      const int t = i >> 6, j = i & 63;
      const float inv = powf(10000.f, -(float)(j & 31) / 32.f);
      const float ang = (float)(j < 32 ? (t >> 6) : (t & 63)) * inv;
      float sn, cs; sincosf(ang, &sn, &cs);
      ct[i] = cs; st[i] = sn;
    }
  }
  {
    float* ct = (float*)(ws + WS_ROPE64); float* st = ct + (size_t)SEQ * 32;
    for (int i = blockIdx.x * NTH + tid; i < SEQ * 32; i += gridDim.x * NTH) {
      const int t = i >> 5, j = i & 31;
      const float inv = powf(10000.f, -(float)(j & 15) / 16.f);
      const float ang = (float)(j < 16 ? (t >> 6) : (t & 63)) * inv;
      float sn, cs; sincosf(ang, &sn, &cs);
      ct[i] = cs; st[i] = sn;
    }
  }
  {
    const int gw = blockIdx.x * 8 + wave, ngw = gridDim.x * 8;
    for (int u = gw; u < 2 * (SEQ + CTX); u += ngw) {
      const int e = u / (SEQ + CTX), rr = u % (SEQ + CTX);
      const int L = rr < SEQ ? SEQ : CTX, r = rr < SEQ ? rr : rr - SEQ;
      float* hid = rr < SEQ ? (float*)(ws + WS_HID) + ((size_t)e * SEQ + r) * 64 : (float*)(ws + WS_HID256) + ((size_t)e * CTX + r) * 64;
      const float* w1 = p.in[14] + e * 33 * 64; const float* b1 = p.in[15] + e * 64; const float* f1 = p.in[16] + e * 64;
      const float* w2 = p.in[17] + e * 64 * 64; const float* b2 = p.in[18] + e * 64; const float* f2 = p.in[19] + e * 64;
      const float tt = (float)r / (float)(L - 1);
      const int b = lane & 15;
      const float band = 1e-4f + (15.f - 1e-4f) * (float)b / 15.f;
      const float cst = (float)(6.283185307179586 / (double)L);
      const float ang = (cst * (float)r) * band;
      float sn, cs; sincosf(ang, &sn, &cs);
      const float val = (lane < 16) ? cs : -sn;
      float acc = b1[lane] + tt * w1[lane];
      for (int f = 1; f < 33; ++f) acc += __shfl(val, f - 1) * w1[f * 64 + lane];
      const float h1 = sinf(f1[lane] * acc);
      float acc2 = b2[lane];
      for (int i = 0; i < 64; ++i) acc2 += __shfl(h1, i) * w2[i * 64 + lane];
      hid[lane] = sinf(f2[lane] * acc2);
    }
  }
}

DI const float* norm_src(const Params& p, int layer, int m) {
  if (layer == 0) return m < CTX ? p.in[2] + (size_t)m * D : p.in[0] + (size_t)(m - CTX) * D;
  return (const float*)(p.ws + WS_H) + (size_t)m * D;
}
DI void phase_norm(const Params& p, int layer) {
  const int tid_ = TIDX(); const int lane = tid_ & 63, wave = tid_ >> 6;
  const int gw = blockIdx.x * 8 + wave, ngw = gridDim.x * 8;
  const float* ng = p.in[6] + layer * D;
  bf16_t* U = (bf16_t*)(p.ws + WS_U);
  f32x4 vn[8];
  if (gw < MR) {
    const float* s0 = norm_src(p, layer, gw);
#pragma unroll
    for (int i = 0; i < 8; ++i) vn[i] = *(const f32x4*)(s0 + (lane + 64 * i) * 4);
  }
  for (int m = gw; m < MR; m += ngw) {
    float* hr = (float*)(p.ws + WS_H) + (size_t)m * D;
    const float* mod = (const float*)(p.ws + WS_MODS) + (size_t)(layer * 2 + (m < CTX ? 1 : 0)) * 6144;
    f32x4 v[8]; float ss = 0.f;
#pragma unroll
    for (int i = 0; i < 8; ++i) { v[i] = vn[i]; ss += v[i][0] * v[i][0] + v[i][1] * v[i][1] + v[i][2] * v[i][2] + v[i][3] * v[i][3]; }
    if (m + ngw < MR) {
      const float* s1 = norm_src(p, layer, m + ngw);
#pragma unroll
      for (int i = 0; i < 8; ++i) vn[i] = *(const f32x4*)(s1 + (lane + 64 * i) * 4);
    }
    if (layer > 0 && m < CTX) {
      const float* gm = (const float*)(p.ws + WS_MODS) + (size_t)((layer - 1) * 2 + 1) * 6144 + 4096;
      const float* part = (const float*)(p.ws + WS_PART) + (size_t)m * D;
      ss = 0.f;
#pragma unroll
      for (int i = 0; i < 8; ++i) {
        const int n = (lane + 64 * i) * 4;
        f32x4 a = *(const f32x4*)(part + n);
#pragma unroll
        for (int kp = 1; kp < 8; ++kp) a += *(const f32x4*)(part + (size_t)kp * CTX * D + n);
        const f32x4 g = *(const f32x4*)(gm + n);
        v[i] += g * a;
        ss += v[i][0] * v[i][0] + v[i][1] * v[i][1] + v[i][2] * v[i][2] + v[i][3] * v[i][3];
      }
    }
    if (layer == 0 || m < CTX) {
#pragma unroll
      for (int i = 0; i < 8; ++i) *(f32x4*)(hr + (lane + 64 * i) * 4) = v[i];
    }
    ss = wave_sum(ss);
    const float rs = rsqrtf(ss * (1.f / D) + EPS);
#pragma unroll
    for (int i = 0; i < 8; ++i) {
      const int n = (lane + 64 * i) * 4;
      const f32x4 g = *(const f32x4*)(ng + n), sh = *(const f32x4*)(mod + n), sc = *(const f32x4*)(mod + 2048 + n);
      float o[4];
#pragma unroll
      for (int j = 0; j < 4; ++j) o[j] = v[i][j] * rs * g[j] * (1.f + sc[j]) + sh[j];
      u32x2 w; w[0] = pk2(o[0], o[1]); w[1] = pk2(o[2], o[3]);
      *(u32x2*)(U + (size_t)m * D + n) = w;
    }
  }
}

DI void taps_unit(const float* __restrict__ hid, int L, const float* __restrict__ w3, float* __restrict__ taps, int rt, int ct0, int nct, int lane) {
  const int h = lane >> 5, l31 = lane & 31;
  const int r = rt * 32 + l31;
  float a[32], b[32];
#pragma unroll
  for (int st = 0; st < 32; ++st) a[st] = hid[(size_t)r * 64 + 2 * st + h];
  const float tr = -LOG2E * (float)r / (float)(L - 1);
  const unsigned woff = (unsigned)(h * 4096 + l31);
#pragma unroll
  for (int st = 0; st < 32; ++st) b[st] = w3[woff + (unsigned)(st * 8192 + ct0 * 32)];
  for (int ct = ct0; ct < ct0 + nct; ++ct) {
    f32x16 acc;
#pragma unroll
    for (int i = 0; i < 16; ++i) acc[i] = 0.f;
#pragma unroll
    for (int st = 0; st < 32; ++st) acc = __builtin_amdgcn_mfma_f32_32x32x2f32(b[st], a[st], acc, 0, 0, 0);
    if (ct + 1 < ct0 + nct) {
#pragma unroll
      for (int st = 0; st < 32; ++st) b[st] = w3[woff + (unsigned)(st * 8192 + (ct + 1) * 32)];
    }
    const int cbase = ct * 32;
    const int o = cbase >> 11, side = (cbase >> 10) & 1;
    float* kp0 = taps + (size_t)(o * 1024 + (cbase & 1023)) * (2 * L);
    const unsigned pos = side == 0 ? (unsigned)r : (r == 0 ? (unsigned)L : (unsigned)(2 * L - r));
#pragma unroll
    for (int i = 0; i < 16; ++i) {
      const int chl = crow(i, h);
      const float delta = DECAY_MAX + (DECAY_MIN - DECAY_MAX) * ((float)((cbase & 1023) + chl) / 1023.f);
      float v = acc[i] * __builtin_amdgcn_exp2f(tr * delta);
      if (side != 0 && r == 0) v = 0.f;
      kp0[(unsigned)(chl * 2 * L) + pos] = v;
    }
  }
}
DI void phase_taps(const Params& p, int e, int b0) {
  const int vb = vblock();
  if (vb < b0) return;
  const int tid_ = TIDX(); const int lane = tid_ & 63, wave = tid_ >> 6;
  const int gw = (vb - b0) * 8 + wave, ngw = ((int)gridDim.x - b0) * 8;
  const float* w3 = p.in[20] + (size_t)e * 64 * 4096;
  for (int u = gw; u < 2048 + 1024; u += ngw) {
    if (u < 2048) taps_unit((const float*)(p.ws + WS_HID) + (size_t)e * SEQ * 64, SEQ, w3, (float*)(p.ws + WS_TAPS), u >> 3, (u & 7) * 16, 16, lane);
    else { const int v = u - 2048; taps_unit((const float*)(p.ws + WS_HID256) + (size_t)e * CTX * 64, CTX, w3, (float*)(p.ws + WS_TAPS256), v >> 7, v & 127, 1, lane); }
  }
}


DI const Params& kargs() {
  const void* q = (const void*)__builtin_amdgcn_kernarg_segment_ptr();
  asm volatile("" : "+s"(q));
  return *(const Params*)q;
}
#define PP kargs()
struct TileFuse { int mode; int e; };
DI void head128_tile(const f32x16 (&acc)[4][2], int mt, int wm, int lane, const float* gv, float post, bool rope, const float* cosT, const float* sinT,
                     const float* rowsq, float rdim, bf16_t* dst, int ld, int col0) {
  const int h = lane >> 5, l31 = lane & 31;
#pragma unroll
  for (int j = 0; j < 2; ++j) {
    const int m = mt * 256 + wm * 64 + j * 32 + l31;
    const bool lat = rope && m >= CTX;
    const float pre = rowsq ? rsqrtf(rowsq[m] * rdim + EPS) : 1.f;
    float ss = 0.f;
#pragma unroll
    for (int i = 0; i < 4; ++i)
#pragma unroll
      for (int r = 0; r < 16; ++r) ss += acc[i][j][r] * acc[i][j][r];
    ss += __shfl_xor(ss, 32);
    const float rs = rsqrtf(ss * pre * pre * (1.f / 128.f) + EPS) * post * pre;
    const float* cr = cosT + (size_t)(lat ? m - CTX : 0) * 64; const float* sr = sinT + (size_t)(lat ? m - CTX : 0) * 64;
    bf16_t* prow = dst + (size_t)m * ld + col0;
#pragma unroll
    for (int i = 0; i < 2; ++i)
#pragma unroll
      for (int g = 0; g < 4; ++g) {
        const int d0 = i * 32 + 8 * g + 4 * h;
        const f32x4 ga = *(const f32x4*)(gv + d0), gb = *(const f32x4*)(gv + d0 + 64);
        f32x4 c4 = {1.f, 1.f, 1.f, 1.f}, s4 = {0.f, 0.f, 0.f, 0.f};
        if (lat) { c4 = *(const f32x4*)(cr + d0); s4 = *(const f32x4*)(sr + d0); }
        float y0[4], y1[4];
#pragma unroll
        for (int jj = 0; jj < 4; ++jj) {
          const float a = acc[i][j][4 * g + jj] * rs * ga[jj], b = acc[i + 2][j][4 * g + jj] * rs * gb[jj];
          y0[jj] = a * c4[jj] - b * s4[jj]; y1[jj] = b * c4[jj] + a * s4[jj];
        }
        u32x2 w0, w1; w0[0] = pk2(y0[0], y0[1]); w0[1] = pk2(y0[2], y0[3]); w1[0] = pk2(y1[0], y1[1]); w1[1] = pk2(y1[2], y1[3]);
        *(u32x2*)(prow + d0) = w0; *(u32x2*)(prow + d0 + 64) = w1;
      }
  }
}
DI void head64_tile(const f32x16 (&acc)[4][2], int i0, int mt, int wm, int lane, const float* gv, float post, const float* cosT, const float* sinT,
                    const float* rowsq, float rdim, bf16_t* dst, int ld, int col0) {
  const int h = lane >> 5, l31 = lane & 31;
#pragma unroll
  for (int j = 0; j < 2; ++j) {
    const int m = mt * 256 + wm * 64 + j * 32 + l31;
    const bool lat = m >= CTX;
    const float pre = rowsq ? rsqrtf(rowsq[m] * rdim + EPS) : 1.f;
    float ss = 0.f;
#pragma unroll
    for (int r = 0; r < 16; ++r) ss += acc[i0][j][r] * acc[i0][j][r] + acc[i0 + 1][j][r] * acc[i0 + 1][j][r];
    ss += __shfl_xor(ss, 32);
    const float rs = rsqrtf(ss * pre * pre * (1.f / 64.f) + EPS) * post * pre;
    const float* cr = cosT + (size_t)(lat ? m - CTX : 0) * 32; const float* sr = sinT + (size_t)(lat ? m - CTX : 0) * 32;
    bf16_t* prow = dst + (size_t)m * ld + col0;
#pragma unroll
    for (int g = 0; g < 4; ++g) {
      const int d0 = 8 * g + 4 * h;
      const f32x4 ga = *(const f32x4*)(gv + d0), gb = *(const f32x4*)(gv + d0 + 32);
      f32x4 c4 = {1.f, 1.f, 1.f, 1.f}, s4 = {0.f, 0.f, 0.f, 0.f};
      if (lat) { c4 = *(const f32x4*)(cr + d0); s4 = *(const f32x4*)(sr + d0); }
      float y0[4], y1[4];
#pragma unroll
      for (int jj = 0; jj < 4; ++jj) {
        const float a = acc[i0][j][4 * g + jj] * rs * ga[jj], b = acc[i0 + 1][j][4 * g + jj] * rs * gb[jj];
        y0[jj] = a * c4[jj] - b * s4[jj]; y1[jj] = b * c4[jj] + a * s4[jj];
      }
      u32x2 w0, w1; w0[0] = pk2(y0[0], y0[1]); w0[1] = pk2(y0[2], y0[3]); w1[0] = pk2(y1[0], y1[1]); w1[1] = pk2(y1[2], y1[3]);
      *(u32x2*)(prow + d0) = w0; *(u32x2*)(prow + d0 + 32) = w1;
    }
  }
}
DI void plain_tile(const f32x16 (&acc)[4][2], int i_lo, int i_hi, int mt, int wm, int lane, bf16_t* dst, int ld, int col0) {
  const int h = lane >> 5, l31 = lane & 31;
#pragma unroll
  for (int i = 0; i < 4; ++i) {
    if (i < i_lo || i >= i_hi) continue;
#pragma unroll
    for (int j = 0; j < 2; ++j)
#pragma unroll
      for (int g = 0; g < 4; ++g) {
        const int m = mt * 256 + wm * 64 + j * 32 + l31;
        u32x2 w; w[0] = pk2(acc[i][j][4 * g], acc[i][j][4 * g + 1]); w[1] = pk2(acc[i][j][4 * g + 2], acc[i][j][4 * g + 3]);
        *(u32x2*)(dst + (size_t)m * ld + col0 + i * 32 + 8 * g + 4 * h) = w;
      }
  }
}
DI bool fused_tile(const f32x16 (&acc)[4][2], int nt, int mt, int wn, int wm, int lane, const TileFuse& tf) {
  const int h = lane >> 5, l31 = lane & 31;
  const int col0 = nt * 256 + wn * 128;
  const int mode = tf.mode, e = tf.e;
  if (mode <= 1) {
    if (!(nt <= 4 || (mode == 1 && nt >= 6 && nt <= 9))) return false;
    const Params& p = kargs();
    bf16_t* dst = (bf16_t*)(p.ws + WS_P); const int ld = mode == 1 ? NPO : NPE;
    const float* cos128 = (const float*)(p.ws + WS_ROPE); const float* sin128 = cos128 + (size_t)SEQ * 64;
    if (nt < 4) { head128_tile(acc, mt, wm, lane, (mode == 1 ? p.in[23] : p.in[9]) + e * 128, QSCALE128, true, cos128, sin128, nullptr, 0.f, dst, ld, col0); return true; }
    if (nt == 4) { head128_tile(acc, mt, wm, lane, (mode == 1 ? p.in[24] : p.in[10]) + e * 128, 1.f, true, cos128, sin128, nullptr, 0.f, dst, ld, col0); return true; }
    if (nt <= 8) {
      plain_tile(acc, 0, 4, mt, wm, lane, dst, ld, col0);
      float* rq = (float*)(p.ws + WS_ROWSQ) + (size_t)e * 2 * MR + (nt == 8 ? MR : 0);
#pragma unroll
      for (int j = 0; j < 2; ++j) {
        float ss = 0.f;
#pragma unroll
        for (int i = 0; i < 4; ++i)
#pragma unroll
          for (int r = 0; r < 16; ++r) ss += acc[i][j][r] * acc[i][j][r];
        ss += __shfl_xor(ss, 32);
        if (h == 0) atomicAdd(rq + mt * 256 + wm * 64 + j * 32 + l31, ss);
      }
      return true;
    }
    if (wn == 0) {
      const float* c64 = (const float*)(p.ws + WS_ROPE64);
      head64_tile(acc, 0, mt, wm, lane, p.in[30] + e * 192 + 128, 1.f, c64, c64 + (size_t)SEQ * 32, nullptr, 0.f, dst, ld, col0);
      plain_tile(acc, 2, 4, mt, wm, lane, dst, ld, col0);
    } else plain_tile(acc, 0, 4, mt, wm, lane, dst, ld, col0);
    return true;
  }
  const Params& p = kargs();
  const float* rowsq = (const float*)(p.ws + WS_ROWSQ) + (size_t)e * 2 * MR + (mode == 3 ? MR : 0);
  if (mode == 2) {
    bf16_t* dst = (bf16_t*)(p.ws + WS_QM);
    if (nt < 4) head128_tile(acc, mt, wm, lane, p.in[29] + e * 192, QSCALE192, false, nullptr, nullptr, rowsq, 1.f / 512.f, dst, 1536, col0);
    else {
      const float* c64 = (const float*)(p.ws + WS_ROPE64);
      head64_tile(acc, 0, mt, wm, lane, p.in[29] + e * 192 + 128, QSCALE192, c64, c64 + (size_t)SEQ * 32, rowsq, 1.f / 512.f, dst, 1536, col0);
      head64_tile(acc, 2, mt, wm, lane, p.in[29] + e * 192 + 128, QSCALE192, c64, c64 + (size_t)SEQ * 32, rowsq, 1.f / 512.f, dst, 1536, col0 + 64);
    }
    return true;
  }
  if (wn == 0) { head128_tile(acc, mt, wm, lane, p.in[30] + e * 192, 1.f, false, nullptr, nullptr, rowsq, 1.f / 256.f, (bf16_t*)(p.ws + WS_KV), 2048, nt * 256); return true; }
  bf16_t* vmt = (bf16_t*)(p.ws + WS_VMT);
#pragma unroll
  for (int j = 0; j < 2; ++j) {
    const int m = mt * 256 + wm * 64 + j * 32 + l31;
    const float pre = rsqrtf(rowsq[m] * (1.f / 256.f) + EPS);
#pragma unroll
    for (int i = 0; i < 4; ++i)
#pragma unroll
      for (int r = 0; r < 16; ++r) vmt[(size_t)(nt * 128 + i * 32 + crow(r, h)) * MR + m] = f2bf(acc[i][j][r] * pre);
  }
  return true;
}

template <class Epi>
DI void gemm_phase(unsigned char* lds, const bf16_t* __restrict__ W, int ldw, const bf16_t* __restrict__ X, int ldx, int N, int M, int K, int mt_begin, const Epi epi, int ksplit = 1, const TileFuse* tf = nullptr) {
  const int tid = TIDX(), lane = tid & 63, wave = tid >> 6, h = lane >> 5, l31 = lane & 31;
  const int wn = wave >> 2, wm = wave & 3;
  const int NTm = M / 256 - mt_begin, NTn = N / 256;
  const int ntiles = NTn * NTm * ksplit, nk = K / 64 / ksplit;
  const int srow = tid >> 3, scn = tid & 7;
  const int soff = srow * 128 + ((scn ^ ((srow >> 1) & 7)) << 4);
  for (int tile = vblock(); tile < ntiles; tile += gridDim.x) {
    const int kp = tile % ksplit, t2 = tile / ksplit;
    const int pg = t2 / (4 * NTm), pr = t2 % (4 * NTm), gsz = (NTn - 4 * pg) < 4 ? (NTn - 4 * pg) : 4;
    const int nt = 4 * pg + pr % gsz, mt = pr / gsz + mt_begin;
    const int cgl = scn ^ ((srow >> 1) & 7);
    const bf16_t* Wp = W + (size_t)(nt * 256 + srow) * ldw + cgl * 8 + kp * nk * 64;
    const bf16_t* Xp = X + (size_t)(mt * 256 + srow) * ldx + cgl * 8 + kp * nk * 64;
    f32x16 acc[4][2];
#pragma unroll
    for (int i = 0; i < 4; ++i)
#pragma unroll
      for (int j = 0; j < 2; ++j)
#pragma unroll
        for (int r = 0; r < 16; ++r) acc[i][j][r] = 0.f;
#define GEMM_STAGE(buf, kt_) do { \
      _Pragma("unroll") for (int i = 0; i < 4; ++i) { \
        __builtin_amdgcn_global_load_lds((const unsigned*)(Wp + (size_t)(64 * i) * ldw + (kt_) * 64), (unsigned*)((buf) + tid * 16 + i * 8192), 16, 0, 0); \
        __builtin_amdgcn_global_load_lds((const unsigned*)(Xp + (size_t)(64 * i) * ldx + (kt_) * 64), (unsigned*)((buf) + 32768 + tid * 16 + i * 8192), 16, 0, 0); } } while (0)
    GEMM_STAGE(lds, 0);
    __syncthreads();
    for (int kt = 0; kt < nk; ++kt) {
      unsigned char* cur = lds + (kt & 1) * 65536;
      unsigned char* nxt = lds + ((kt + 1) & 1) * 65536;
      if (kt + 1 < nk) GEMM_STAGE(nxt, kt + 1);
      __builtin_amdgcn_sched_barrier(0);
#pragma unroll
      for (int s = 0; s < 4; ++s) {
        const int c = ((2 * s + h) ^ ((l31 >> 1) & 7)) << 4;
        bf16x8 a[4], b[2];
#pragma unroll
        for (int i = 0; i < 4; ++i) a[i] = *(const bf16x8*)(cur + (wn * 128 + i * 32 + l31) * 128 + c);
#pragma unroll
        for (int j = 0; j < 2; ++j) b[j] = *(const bf16x8*)(cur + 32768 + (wm * 64 + j * 32 + l31) * 128 + c);
#pragma unroll
        for (int i = 0; i < 4; ++i)
#pragma unroll
          for (int j = 0; j < 2; ++j) acc[i][j] = MFMA16(a[i], b[j], acc[i][j]);
      }
      __syncthreads();
    }
#undef GEMM_STAGE
    if (tf != nullptr && fused_tile(acc, nt, mt, wn, wm, lane, *tf)) continue;
#pragma unroll
    for (int i = 0; i < 4; ++i)
#pragma unroll
      for (int j = 0; j < 2; ++j)
#pragma unroll
        for (int g = 0; g < 4; ++g) {
          const int n = nt * 256 + wn * 128 + i * 32 + 8 * g + 4 * h;
          const int m = mt * 256 + wm * 64 + j * 32 + l31;
          epi(m, n, acc[i][j][4 * g], acc[i][j][4 * g + 1], acc[i][j][4 * g + 2], acc[i][j][4 * g + 3], kp);
        }
  }
}
struct EpiIn {
  bf16_t* P; int ldp; int nvalid; bf16_t* Vt; bf16_t* PT; int hy_lo, hy_hi; bf16_t* GT; int gt_lo;
  DI void operator()(int m, int n, float a, float b, float c, float d, int kp) const {
    if (n >= nvalid) return;
    bf16_t* v = nullptr;
    if (n >= 1280 && n < 1536) v = Vt + (size_t)(n - 1280) * MR + m;
    else if (n >= hy_lo && n < hy_hi) v = PT + (size_t)(n - hy_lo) * MR + m;
    else if (n >= gt_lo) v = GT + (size_t)(n - gt_lo) * MR + m;
    if (v != nullptr) { v[0] = f2bf(a); v[MR] = f2bf(b); v[2 * MR] = f2bf(c); v[3 * MR] = f2bf(d); }
    else {
      u32x2 w; w[0] = pk2(a, b); w[1] = pk2(c, d);
      *(u32x2*)(P + (size_t)m * ldp + n) = w;
    }
  }
};
struct EpiUQ {
  bf16_t* Q;
  DI void operator()(int m, int n, float a, float b, float c, float d, int kp) const {
    u32x2 w; w[0] = pk2(a, b); w[1] = pk2(c, d);
    *(u32x2*)(Q + (size_t)m * 1536 + n) = w;
  }
};
struct EpiUKV {
  bf16_t* KV; bf16_t* Vmt;
  DI void operator()(int m, int n, float a, float b, float c, float d, int kp) const {
    const int w_ = n & 255, hd = n >> 8;
    if (w_ >= 128) {
      bf16_t* v = Vmt + (size_t)(hd * 128 + w_ - 128) * MR + m;
      v[0] = f2bf(a); v[MR] = f2bf(b); v[2 * MR] = f2bf(c); v[3 * MR] = f2bf(d);
    } else {
      u32x2 w; w[0] = pk2(a, b); w[1] = pk2(c, d);
      *(u32x2*)(KV + (size_t)m * 2048 + n) = w;
    }
  }
};
struct EpiOut {
  float* H; float* dout; const float* mods; int layer;
  DI void operator()(int m, int n, float a, float b, float c, float d, int kp) const {
    const f32x4 hv = *(const f32x4*)(H + (size_t)m * D + n);
    const f32x4 g = *(const f32x4*)(mods + (size_t)(layer * 2 + (m < CTX ? 1 : 0)) * 6144 + 4096 + n);
    f32x4 o; o[0] = hv[0] + g[0] * a; o[1] = hv[1] + g[1] * b; o[2] = hv[2] + g[2] * c; o[3] = hv[3] + g[3] * d;
    if (layer == 3) { if (m >= CTX) *(f32x4*)(dout + (size_t)(m - CTX) * D + n) = o; }
    else *(f32x4*)(H + (size_t)m * D + n) = o;
  }
};

struct EpiOutPart {
  float* PART;
  DI void operator()(int m, int n, float a, float b, float c, float d, int kp) const {
    *(f32x4*)(PART + ((size_t)kp * CTX + m) * D + n) = (f32x4){a, b, c, d};
  }
};

DI void head_norm128(bf16_t* px, const float* g, bool rope, float cs, float sn, int lane) {
  const float x0 = bf2f(px[lane]), x1 = bf2f(px[lane + 64]);
  const float ss = wave_sum(x0 * x0 + x1 * x1);
  const float rs = rsqrtf(ss * (1.f / 128.f) + EPS);
  float y0 = x0 * rs * g[lane], y1 = x1 * rs * g[lane + 64];
  if (rope) { const float a = y0 * cs - y1 * sn, b = y1 * cs + y0 * sn; y0 = a; y1 = b; }
  px[lane] = f2bf(y0); px[lane + 64] = f2bf(y1);
}
DI void head_norm64(bf16_t* px, const float* g, bool rope, float cs, float sn, int lane) {
  float x0 = 0.f, x1 = 0.f;
  if (lane < 32) { x0 = bf2f(px[lane]); x1 = bf2f(px[lane + 32]); }
  const float ss = wave_sum(x0 * x0 + x1 * x1);
  const float rs = rsqrtf(ss * (1.f / 64.f) + EPS);
  if (lane < 32) {
    float y0 = x0 * rs * g[lane], y1 = x1 * rs * g[lane + 32];
    if (rope) { const float a = y0 * cs - y1 * sn, b = y1 * cs + y0 * sn; y0 = a; y1 = b; }
    px[lane] = f2bf(y0); px[lane + 32] = f2bf(y1);
  }
}

template <int NH>
DI void heads_norm128(bf16_t* base, int stride, const float* g, bool rope, float cs, float sn, int lane, float post = 1.f) {
  float x0[NH], x1[NH];
#pragma unroll
  for (int i = 0; i < NH; ++i) { x0[i] = bf2f(base[i * stride + lane]); x1[i] = bf2f(base[i * stride + lane + 64]); }
  const float g0 = g[lane], g1 = g[lane + 64];
  float ss[NH];
#pragma unroll
  for (int i = 0; i < NH; ++i) ss[i] = x0[i] * x0[i] + x1[i] * x1[i];
#pragma unroll
  for (int o = 32; o > 0; o >>= 1) {
#pragma unroll
    for (int i = 0; i < NH; ++i) ss[i] += __shfl_xor(ss[i], o);
  }
#pragma unroll
  for (int i = 0; i < NH; ++i) {
    const float rs = rsqrtf(ss[i] * (1.f / 128.f) + EPS) * post;
    float y0 = x0[i] * rs * g0, y1 = x1[i] * rs * g1;
    if (rope) { const float a = y0 * cs - y1 * sn, b = y1 * cs + y0 * sn; y0 = a; y1 = b; }
    base[i * stride + lane] = f2bf(y0); base[i * stride + lane + 64] = f2bf(y1);
  }
}
template <int NH>
DI void heads_norm64(bf16_t* base, int stride, const float* g, bool rope, float cs, float sn, int lane, float post = 1.f) {
  float x0[NH], x1[NH];
  const int l = lane & 31;
#pragma unroll
  for (int i = 0; i < NH; ++i) { x0[i] = bf2f(base[i * stride + l]); x1[i] = bf2f(base[i * stride + l + 32]); }
  const float g0 = g[l], g1 = g[l + 32];
  float ss[NH];
#pragma unroll
  for (int i = 0; i < NH; ++i) ss[i] = x0[i] * x0[i] + x1[i] * x1[i];
#pragma unroll
  for (int o = 16; o > 0; o >>= 1) {
#pragma unroll
    for (int i = 0; i < NH; ++i) ss[i] += __shfl_xor(ss[i], o);
  }
  if (lane < 32) {
#pragma unroll
    for (int i = 0; i < NH; ++i) {
      const float rs = rsqrtf(ss[i] * (1.f / 64.f) + EPS) * post;
      float y0 = x0[i] * rs * g0, y1 = x1[i] * rs * g1;
      if (rope) { const float a = y0 * cs - y1 * sn, b = y1 * cs + y0 * sn; y0 = a; y1 = b; }
      base[i * stride + l] = f2bf(y0); base[i * stride + l + 32] = f2bf(y1);
    }
  }
}
DI void rope_angles(int t, int lane, float& cs128, float& sn128, float& cs64, float& sn64) {
  const int row = t >> 6, col = t & 63;
  {
    const int f = lane & 31;
    const float inv = powf(10000.f, -(float)f / 32.f);
    const float ang = (float)(lane < 32 ? row : col) * inv;
    sincosf(ang, &sn128, &cs128);
  }
  {
    const int j = lane & 31, f = j & 15;
    const float inv = powf(10000.f, -(float)f / 16.f);
    const float ang = (float)(j < 16 ? row : col) * inv;
    sincosf(ang, &sn64, &cs64);
  }
}
DI void phase_rowops(const Params& p, int layer) {
  const int tid_ = TIDX(); const int lane = tid_ & 63, wave = tid_ >> 6;
  const int gw = blockIdx.x * 8 + wave, ngw = gridDim.x * 8;
  const bool odd = layer & 1; const int e = layer >> 1;
  const int ld = odd ? NPO : NPE;
  bf16_t* P = (bf16_t*)(p.ws + WS_P);
  const float* qg = (odd ? p.in[23] : p.in[9]) + e * 128;
  const float* kg = (odd ? p.in[24] : p.in[10]) + e * 128;
  for (int m = gw; m < MR; m += ngw) {
    const bool lat = m >= CTX;
    float cs128 = 1.f, sn128 = 0.f, cs64 = 1.f, sn64 = 0.f;
    if (lat) rope_angles(m - CTX, lane, cs128, sn128, cs64, sn64);
    bf16_t* row = P + (size_t)m * ld;
    if (odd) {
      {
        const float* g = p.in[25] + e * 512;
        bf16_t* px = row + 1536 + lane * 8;
        float x[8]; float ss = 0.f;
#pragma unroll
        for (int j = 0; j < 8; ++j) { x[j] = bf2f(px[j]); ss += x[j] * x[j]; }
        ss = wave_sum(ss);
        const float rs = rsqrtf(ss * (1.f / 512.f) + EPS);
#pragma unroll
        for (int j = 0; j < 8; ++j) px[j] = f2bf(x[j] * rs * g[lane * 8 + j]);
      }
      {
        const float* g = p.in[26] + e * 256;
        bf16_t* px = row + 2048 + lane * 4;
        float x[4]; float ss = 0.f;
#pragma unroll
        for (int j = 0; j < 4; ++j) { x[j] = bf2f(px[j]); ss += x[j] * x[j]; }
        ss = wave_sum(ss);
        const float rs = rsqrtf(ss * (1.f / 256.f) + EPS);
#pragma unroll
        for (int j = 0; j < 4; ++j) px[j] = f2bf(x[j] * rs * g[lane * 4 + j]);
      }
      heads_norm64<1>(row + 2304, 0, p.in[30] + e * 192 + 128, lat, cs64, sn64, lane);
    }
  }
}
DI void phase_mla_norm(const Params& p, int layer) {
  const int tid_ = TIDX(); const int lane = tid_ & 63, wave = tid_ >> 6;
  const int gw = blockIdx.x * 8 + wave, ngw = gridDim.x * 8;
  const int e = layer >> 1;
  bf16_t* QM = (bf16_t*)(p.ws + WS_QM); bf16_t* KV = (bf16_t*)(p.ws + WS_KV);
  const float* mqg = p.in[29] + e * 192; const float* mkg = p.in[30] + e * 192;
  for (int m = gw; m < MR; m += ngw) {
    const bool lat = m >= CTX;
    float cs128 = 1.f, sn128 = 0.f, cs64 = 1.f, sn64 = 0.f;
    if (lat) rope_angles(m - CTX, lane, cs128, sn128, cs64, sn64);
    heads_norm128<8>(QM + (size_t)m * 1536, 192, mqg, false, 1.f, 0.f, lane, QSCALE192);
    heads_norm64<8>(QM + (size_t)m * 1536 + 128, 192, mqg + 128, lat, cs64, sn64, lane, QSCALE192);
    heads_norm128<8>(KV + (size_t)m * 2048, 256, mkg, false, 1.f, 0.f, lane);
  }
}

DI float block_sum(float v, float* red, int tid) {
  v = wave_sum(v);
  __syncthreads();
  if ((tid & 63) == 0) red[tid >> 6] = v;
  __syncthreads();
  float s = 0.f;
#pragma unroll
  for (int i = 0; i < 8; ++i) s += red[i];
  return s;
}
DI float conv3_at(const bf16_t* pc, int t, float w0, float w1, float w2, float b) {
  const float pm = bf2f(pc[t - 1]), p0 = bf2f(pc[t]), pp = bf2f(pc[t + 1]);
  return w0 * (t > 0 ? pm : 0.f) + w1 * p0 + w2 * (t < SEQ - 1 ? pp : 0.f) + b;
}
DI int rev4(int x) { const unsigned r = __brev((unsigned)x) >> 18; return (int)(((r & 0x2AAAu) >> 1) | ((r & 0x1555u) << 1)); }
DI void hyena_item(const Params& p, unsigned char* lds, int e, int it) {
  c32* X = (c32*)lds; float* red = (float*)(lds + LDS_RED);
  const c32* TW = (const c32*)(lds + LDS_WT);
  const bf16_t* PT = (const bf16_t*)(p.ws + WS_XT);
  const bf16_t* GTp = (const bf16_t*)(p.ws + WS_YT);
  bf16_t* O = (bf16_t*)(p.ws + WS_O);
  const float* hb = p.in[21] + (size_t)e * 2 * 1024;
  const float* cw = p.in[12] + (size_t)e * 3 * 3072; const float* cb = p.in[13] + (size_t)e * 3072;
  unsigned outp[16];
  for (int c = 0; c < 4; ++c) {
    const int ch = 4 * it + c;
    float zreg[16];
    for (int o = 0; o < 2; ++o) {
      const int tid = TIDX();
      const float* tp = (const float*)(p.ws + WS_TAPS) + (size_t)(o * 1024 + ch) * FN;
      float kv[32];
#pragma unroll
      for (int m = 0; m < 32; ++m) kv[m] = tp[tid + NTH * m];
      if (o == 0) {
        const int col = 2048 + ch;
        const bf16_t* pc = PT + (size_t)col * MR + CTX;
        const float w0 = cw[col], w1 = cw[3072 + col], w2 = cw[2 * 3072 + col], bb = cb[col];
#pragma unroll
        for (int m = 0; m < 16; ++m) zreg[m] = conv3_at(pc, tid + NTH * m, w0, w1, w2, bb);
      }
      float sabs = 0.f;
#pragma unroll
      for (int m = 0; m < 32; ++m) { X[PADI(tid + NTH * m)] = {kv[m], m < 16 ? zreg[m & 15] : 0.f}; sabs += fabsf(kv[m]); }
      const float tot = block_sum(sabs, red, tid);
      const float inv = 1.f / tot;
      fft_fwd3(X, TW, tid);
#pragma unroll 2
      for (int m = 0; m < 4; ++m) {
        const int w = tid + NTH * m;
        const int gi = ((w >> 1) << 2) | (w & 1);
        const int g2 = (w == 0) ? 2 : rev6(4096 - rev6(gi));
        c32* pa = X + PADI(4 * gi); c32* pb = X + PADI(4 * g2);
        c32 A0 = pa[0], A1 = pa[1], A2 = pa[2], A3 = pa[3], B0 = pb[0], B1 = pb[1], B2 = pb[2], B3 = pb[3];
        fwd4(A0, A1, A2, A3, A0, A0, A0, false);
        fwd4(B0, B1, B2, B3, B0, B0, B0, false);
        if (w == 0) {
          A0 = {A0.x * A0.y * inv, 0.f}; A2 = {A2.x * A2.y * inv, 0.f}; pairprod(A1, A3, inv);
          pairprod(B0, B3, inv); pairprod(B1, B2, inv);
        } else { pairprod(A0, B3, inv); pairprod(A1, B2, inv); pairprod(A2, B1, inv); pairprod(A3, B0, inv); }
        inv4(A0, A1, A2, A3, A0, A0, A0, false);
        inv4(B0, B1, B2, B3, B0, B0, B0, false);
        pa[0] = A0; pa[1] = A1; pa[2] = A2; pa[3] = A3; pb[0] = B0; pb[1] = B1; pb[2] = B2; pb[3] = B3;
      }
      __syncthreads();
      fft_inv3(X, TW, tid);
      const float bias = hb[o * 1024 + ch];
      const int col = (o == 0 ? 0 : 1024) + ch;
      const bf16_t* pc = PT + (size_t)col * MR + CTX;
      const float w0 = cw[col], w1 = cw[3072 + col], w2 = cw[2 * 3072 + col], bb = cb[col];
      float xg[16], gt[16];
#pragma unroll
      for (int m = 0; m < 16; ++m) {
        const int t = tid + NTH * m;
        xg[m] = conv3_at(pc, t, w0, w1, w2, bb);
        gt[m] = o == 0 ? 0.f : bf2f(GTp[(size_t)ch * MR + CTX + t]);
      }
#pragma unroll
      for (int m = 0; m < 16; ++m) {
        const int t = tid + NTH * m;
        const float y = X[PADI(t)].x * (1.f / (float)FN);
        const float r = xg[m] * (y + bias * zreg[m]);
        if (o == 0) zreg[m] = r;
        else {
          const unsigned hv = (unsigned)f2bf(r * silu_f(gt[m]));
          if ((c & 1) == 0) outp[m] = hv;
          else *(unsigned*)(O + (size_t)(CTX + t) * D + 1024 + 4 * it + c - 1) = outp[m] | (hv << 16);
        }
      }
      __syncthreads();
    }
  }
}
DI void hyena_ctx_item(const Params& p, unsigned char* lds, int e, int it) {
  float* kk = (float*)lds;
  float* zz = kk + 1024;
  float* red = (float*)(lds + LDS_RED);
  const int tid = TIDX(), half = tid >> 8, t = tid & 255, ch = 2 * it + half;
  const bf16_t* P = (const bf16_t*)(p.ws + WS_P);
  bf16_t* O = (bf16_t*)(p.ws + WS_O);
  const float* cw = p.in[12] + (size_t)e * 3 * 3072; const float* cb = p.in[13] + (size_t)e * 3072;
  const float* hb = p.in[21] + (size_t)e * 2 * 1024;
  float u3[3];
#pragma unroll
  for (int q = 0; q < 3; ++q) {
    const int col = q * 1024 + ch;
    const bf16_t* pr = (const bf16_t*)(p.ws + WS_XT) + (size_t)col * MR;
    const float pm = t > 0 ? bf2f(pr[t - 1]) : 0.f;
    const float pc = bf2f(pr[t]);
    const float pp = t < CTX - 1 ? bf2f(pr[t + 1]) : 0.f;
    u3[q] = cw[col] * pm + cw[3072 + col] * pc + cw[2 * 3072 + col] * pp + cb[col];
  }
  float zin = u3[2];
  for (int o = 0; o < 2; ++o) {
    const float* tp = (const float*)(p.ws + WS_TAPS256) + (size_t)(o * 1024 + ch) * 512;
    const float k0 = tp[t], k1 = tp[t + 256];
    kk[half * 512 + t] = k0; kk[half * 512 + t + 256] = k1; zz[half * 256 + t] = zin;
    float sa = wave_sum(fabsf(k0) + fabsf(k1));
    __syncthreads();
    if ((tid & 63) == 0) red[tid >> 6] = sa;
    __syncthreads();
    const float tot = red[half * 4] + red[half * 4 + 1] + red[half * 4 + 2] + red[half * 4 + 3];
    float y0 = 0.f, y1 = 0.f, y2 = 0.f, y3 = 0.f;
    const float* kq = kk + half * 512; const float* zq = zz + half * 256;
#pragma unroll 4
    for (int s = 0; s < 256; s += 4) {
      const f32x4 z4 = *(const f32x4*)(zq + s);
      y0 += kq[(t - s) & 511] * z4[0]; y1 += kq[(t - s - 1) & 511] * z4[1]; y2 += kq[(t - s - 2) & 511] * z4[2]; y3 += kq[(t - s - 3) & 511] * z4[3];
    }
    float y = ((y0 + y1) + (y2 + y3)) / tot;
    const float bias = hb[o * 1024 + ch];
    if (o == 0) zin = u3[0] * (y + bias * zin);
    else {
      const float g = bf2f(((const bf16_t*)(p.ws + WS_YT))[(size_t)ch * MR + t]);
      O[(size_t)t * D + 1024 + ch] = f2bf(u3[1] * (y + bias * zin) * silu_f(g));
    }
    __syncthreads();
  }
}

template <int DK>
DI void attn_item(unsigned char* lds, const bf16_t* __restrict__ Qp, int ldq, const bf16_t* __restrict__ Kp, int ldk,
                  const bf16_t* __restrict__ Krp, int ldkr, const bf16_t* __restrict__ Vtp, const bf16_t* __restrict__ Qrp,
                  int qrow0, int r0n, int r1s, int r1n, bool window, bool has_sink, float sinkv, float sc,
                  const bf16_t* __restrict__ Gp, int ldg, bf16_t* __restrict__ Op, int ldo) {
  constexpr int KB = 64 * DK * 2, BUF = KB + 16384, NCH = DK / 8, NST = DK / 16;
  const int tid = TIDX(), lane = tid & 63, wave = tid >> 6, h = lane >> 5, l31 = lane & 31;
  const int qrow = qrow0 + wave * 32 + l31;
  bf16x8 qf[NST];
#pragma unroll
  for (int st = 0; st < NST; ++st) qf[st] = st < 8 ? *(const bf16x8*)(Qp + (size_t)qrow * ldq + 16 * st + 8 * h) : *(const bf16x8*)(Qrp + (size_t)qrow * ldq + 16 * (st - 8) + 8 * h);
  f32x16 oacc[4];
#pragma unroll
  for (int i = 0; i < 4; ++i)
#pragma unroll
    for (int r = 0; r < 16; ++r) oacc[i][r] = 0.f;
  float m_run = has_sink ? sinkv * LOG2E : -1e30f;
  float l_run = (has_sink && h == 0) ? 1.f : 0.f;
  const int nt = r0n + r1n;
  unsigned koff[NCH / 8], voff[2];
  bool kext[NCH / 8];
#pragma unroll
  for (int i = 0; i < NCH / 8; ++i) {
    const int id = tid + NTH * i, kr = id / NCH, ks = id % NCH;
    const int kc = DK == 128 ? (ks ^ (kr & 15)) : ((ks & ~7) | ((ks & 7) ^ (kr & 7)));
    kext[i] = kc >= 16;
    koff[i] = kc < 16 ? (unsigned)(kr * ldk + kc * 8) * 2u : (unsigned)(kr * ldkr + (kc - 16) * 8) * 2u;
  }
#pragma unroll
  for (int i = 0; i < 2; ++i) {
    const int vr = (tid >> 3) + 64 * i, vs = tid & 7;
    voff[i] = (unsigned)(vr * MR + (vs ^ ((vr >> 1) & 7)) * 8) * 2u;
  }
#define ATT_STAGE(ti, b) do { const int r0_ = (ti) < r0n ? 64 * (ti) : r1s + 64 * ((ti) - r0n); unsigned char* base_ = lds + (b) * BUF; \
    const char* kb_ = (const char*)Kp + (size_t)r0_ * ldk * 2; const char* kb2_ = (const char*)Krp + (size_t)r0_ * ldkr * 2; const char* vb_ = (const char*)Vtp + (size_t)r0_ * 2; \
    _Pragma("unroll") for (int i = 0; i < NCH / 8; ++i) __builtin_amdgcn_global_load_lds((const unsigned*)((kext[i] ? kb2_ : kb_) + koff[i]), (unsigned*)(base_ + (tid + NTH * i) * 16), 16, 0, 0); \
    _Pragma("unroll") for (int i = 0; i < 2; ++i) __builtin_amdgcn_global_load_lds((const unsigned*)(vb_ + voff[i]), (unsigned*)(base_ + KB + (tid + NTH * i) * 16), 16, 0, 0); } while (0)
  ATT_STAGE(0, 0);
  __syncthreads();
  for (int ti = 0; ti < nt; ++ti) {
    const unsigned char* cur = lds + (ti & 1) * BUF;
    const bool more = ti + 1 < nt;
    if (more) ATT_STAGE(ti + 1, (ti + 1) & 1);
    __builtin_amdgcn_sched_barrier(0);
    const int r0 = ti < r0n ? 64 * ti : r1s + 64 * (ti - r0n);
    f32x16 s0, s1;
#pragma unroll
    for (int r = 0; r < 16; ++r) { s0[r] = 0.f; s1[r] = 0.f; }
    {
      bf16x8 ka[2], kb[2];
      {
        const int co = (DK == 128 ? (h ^ (l31 & 15)) : ((h & ~7) | ((h & 7) ^ (l31 & 7)))) << 4;
        ka[0] = *(const bf16x8*)(cur + l31 * (DK * 2) + co); kb[0] = *(const bf16x8*)(cur + (32 + l31) * (DK * 2) + co);
      }
#pragma unroll
      for (int st = 0; st < NST; ++st) {
        if (st + 1 < NST) {
          const int c = 2 * (st + 1) + h;
          const int co = (DK == 128 ? (c ^ (l31 & 15)) : ((c & ~7) | ((c & 7) ^ (l31 & 7)))) << 4;
          ka[(st + 1) & 1] = *(const bf16x8*)(cur + l31 * (DK * 2) + co);
          kb[(st + 1) & 1] = *(const bf16x8*)(cur + (32 + l31) * (DK * 2) + co);
        }
        __builtin_amdgcn_sched_barrier(0);
        s0 = MFMA16(ka[st & 1], qf[st], s0);
        s1 = MFMA16(kb[st & 1], qf[st], s1);
        __builtin_amdgcn_sched_barrier(0);
      }
    }
    float mx = -INFINITY;
    if (window) {
#pragma unroll
      for (int r = 0; r < 16; ++r) {
        const int k0r = r0 + crow(r, h), k1r = k0r + 32;
        const int dq0 = (qrow - k0r), dq1 = (qrow - k1r);
        if (k0r >= CTX && (dq0 > 128 || dq0 < -128)) s0[r] = -INFINITY;
        if (k1r >= CTX && (dq1 > 128 || dq1 < -128)) s1[r] = -INFINITY;
      }
    }
#pragma unroll
    for (int r = 0; r < 16; ++r) mx = fmaxf(mx, fmaxf(s0[r], s1[r]));
    mx = fmaxf(mx, __shfl_xor(mx, 32));
    const float m_new = fmaxf(m_run, mx);
    if (__builtin_amdgcn_ballot_w64(m_new > m_run) != 0ull) {
      const float alpha = __builtin_amdgcn_exp2f(m_run - m_new);
      l_run *= alpha;
#pragma unroll
      for (int i = 0; i < 4; ++i)
#pragma unroll
        for (int r = 0; r < 16; ++r) oacc[i][r] *= alpha;
    }
    m_run = m_new;
    float ls = 0.f;
#pragma unroll
    for (int r = 0; r < 16; ++r) {
      const float p0 = __builtin_amdgcn_exp2f(s0[r] - m_new), p1 = __builtin_amdgcn_exp2f(s1[r] - m_new);
      s0[r] = p0; s1[r] = p1; ls += p0 + p1;
    }
    l_run += ls;
    bf16x8 pf[2][2];
#pragma unroll
    for (int s2 = 0; s2 < 2; ++s2) {
      u32x4 w0, w1;
#pragma unroll
      for (int q = 0; q < 4; ++q) { w0[q] = pk2(s0[8 * s2 + 2 * q], s0[8 * s2 + 2 * q + 1]); w1[q] = pk2(s1[8 * s2 + 2 * q], s1[8 * s2 + 2 * q + 1]); }
      pf[0][s2] = __builtin_bit_cast(bf16x8, w0); pf[1][s2] = __builtin_bit_cast(bf16x8, w1);
    }
    if (true) {
      bf16x8 va[2];
#define VFRAG(u_) [&]() { const int dvt_ = (u_) >> 2, c0_ = ((u_) & 3) * 2; const int vr_ = dvt_ * 32 + l31; const unsigned char* vb_ = cur + KB + vr_ * 128 + 8 * h; const int sw_ = (vr_ >> 1) & 7; \
        const s16x4 lo_ = *(const s16x4*)(vb_ + ((c0_ ^ sw_) << 4)); const s16x4 hi_ = *(const s16x4*)(vb_ + (((c0_ + 1) ^ sw_) << 4)); return (bf16x8)__builtin_shufflevector(lo_, hi_, 0, 1, 2, 3, 4, 5, 6, 7); }()
      va[0] = VFRAG(0);
#pragma unroll
      for (int u = 0; u < 16; ++u) {
        if (u + 1 < 16) va[(u + 1) & 1] = VFRAG(u + 1);
        __builtin_amdgcn_sched_barrier(0);
        oacc[u >> 2] = MFMA16(va[u & 1], pf[(u >> 1) & 1][u & 1], oacc[u >> 2]);
        __builtin_amdgcn_sched_barrier(0);
      }
#undef VFRAG
    } else {
#pragma unroll
    for (int dvt = 0; dvt < 4; ++dvt) {
      const int vr = dvt * 32 + l31;
      const unsigned char* vb = cur + KB + vr * 128 + 8 * h;
      const int sw = (vr >> 1) & 7;
#pragma unroll
      for (int sub = 0; sub < 2; ++sub)
#pragma unroll
        for (int s2 = 0; s2 < 2; ++s2) {
          const int c0 = sub * 4 + 2 * s2;
          const s16x4 lo = *(const s16x4*)(vb + ((c0 ^ sw) << 4));
          const s16x4 hi = *(const s16x4*)(vb + (((c0 + 1) ^ sw) << 4));
          const bf16x8 a = __builtin_shufflevector(lo, hi, 0, 1, 2, 3, 4, 5, 6, 7);
          oacc[dvt] = MFMA16(a, pf[sub][s2], oacc[dvt]);
        }
      __builtin_amdgcn_sched_barrier(0);
    }
    }
    __syncthreads();
  }
#undef ATT_STAGE
  const float l_tot = l_run + __shfl_xor(l_run, 32);
  const float inv = 1.f / l_tot;
#pragma unroll
  for (int dvt = 0; dvt < 4; ++dvt)
#pragma unroll
    for (int g = 0; g < 4; ++g) {
      const int dv = dvt * 32 + 8 * g + 4 * h;
      const u32x2 gw = *(const u32x2*)(Gp + (size_t)qrow * ldg + dv);
      const float g0 = __uint_as_float(gw[0] << 16), g1 = __uint_as_float(gw[0] & 0xffff0000u), g2 = __uint_as_float(gw[1] << 16), g3 = __uint_as_float(gw[1] & 0xffff0000u);
      u32x2 w;
      w[0] = pk2(oacc[dvt][4 * g] * inv * silu_f(g0), oacc[dvt][4 * g + 1] * inv * silu_f(g1));
      w[1] = pk2(oacc[dvt][4 * g + 2] * inv * silu_f(g2), oacc[dvt][4 * g + 3] * inv * silu_f(g3));
      *(u32x2*)(Op + (size_t)qrow * ldo + dv) = w;
    }
}

template <bool odd>
DI void attn_items_AC(const Params& p, unsigned char* lds, int layer, int item) {
  const int e = layer >> 1;
  const int ld = odd ? NPO : NPE; const int goff = odd ? 2368 : 4608;
  const bf16_t* P = (const bf16_t*)(p.ws + WS_P);
  bf16_t* O = (bf16_t*)(p.ws + WS_O);
  const int hd = item & 7, qb = item >> 3;
  const int kvh = hd >> 2;
  const bool isctx = qb == 32;
  const int qrow0 = isctx ? 0 : CTX + qb * 256;
  int r0n = 4, r1s = CTX, r1n = 0; bool window = false;
  if (!isctx) {
    if (odd) { r1s = CTX; r1n = SEQ / 64; }
    else { int s0 = qb * 256 - 128, s1 = qb * 256 + 256 + 128; if (s0 < 0) s0 = 0; if (s1 > SEQ) s1 = SEQ; r1s = CTX + s0; r1n = (s1 - s0) / 64; window = true; }
  }
  const bool has_sink = !odd;
  const float sinkv = has_sink ? p.in[11][e * 8 + hd] : 0.f;
  attn_item<128>(lds, P + hd * 128, ld, P + 1024 + kvh * 128, ld, nullptr, 0, (const bf16_t*)(p.ws + WS_VT) + (size_t)kvh * 128 * MR, nullptr,
                 qrow0, r0n, r1s, r1n, window, has_sink, sinkv, 0.08838834764831845f * LOG2E, P + goff + hd * 128, ld, O + hd * 128, D);
}
DI void attn_items_D(const Params& p, unsigned char* lds, int item) {
  const bf16_t* P = (const bf16_t*)(p.ws + WS_P);
  bf16_t* O = (bf16_t*)(p.ws + WS_O);
  const int hd = item & 7, qb = item >> 3;
  const bool isctx = qb == 32;
  const int qrow0 = isctx ? 0 : CTX + qb * 256;
  const int r1n = isctx ? 0 : SEQ / 64;
  attn_item<192>(lds, (const bf16_t*)(p.ws + WS_QM) + hd * 128, 1536, (const bf16_t*)(p.ws + WS_KV) + hd * 256, 2048, P + 2304, NPO,
                 (const bf16_t*)(p.ws + WS_VMT) + (size_t)hd * 128 * MR, (const bf16_t*)(p.ws + WS_QM) + 1024 + hd * 64, qrow0, 4, CTX, r1n, false, false, 0.f, 0.07216878364870322f * LOG2E,
                 P + 2368 + 1024 + hd * 128, NPO, O + 1024 + hd * 128, D);
}

template <bool odd>
DI void layer_body(unsigned char* lds, int layer) {
  const int e = layer >> 1;
  phase_norm(PP, layer);
  grid_barrier((unsigned*)(PP.ws + WS_BAR), (volatile unsigned*)(lds + LDS_RED + 128), TIDX());
  {
    EpiIn ep{(bf16_t*)(PP.ws + WS_P), odd ? NPO : NPE, odd ? NVO : NPE, (bf16_t*)(PP.ws + WS_VT), (bf16_t*)(PP.ws + WS_XT), odd ? 0 : 1536, odd ? 0 : 4608, (bf16_t*)(PP.ws + WS_YT), odd ? (1 << 30) : 5632};
    const bf16_t* W = odd ? (const bf16_t*)(PP.ws + WS_WTIN_O) + (size_t)e * NPO * D : (const bf16_t*)(PP.ws + WS_WTIN_E) + (size_t)e * NPE * D;
    const Params& q_ = PP;
    const TileFuse tfi{odd ? 1 : 0, e};
    gemm_phase(lds, W, D, (const bf16_t*)(PP.ws + WS_U), D, odd ? NPO : NPE, MR, D, 0, ep, 1, &tfi);
    if (layer < 2) { const int nt_ = odd ? 33 * 18 : 33 * 26; phase_taps(PP, layer, nt_ % (int)gridDim.x); }
  }
  grid_barrier((unsigned*)(PP.ws + WS_BAR), (volatile unsigned*)(lds + LDS_RED + 128), TIDX());
  if (odd) {
    {
      const Params& q2 = PP;
      EpiUQ eq{(bf16_t*)(q2.ws + WS_QM)};
      const TileFuse tfq{2, e};
      gemm_phase(lds, (const bf16_t*)(q2.ws + WS_WTUQ) + (size_t)e * 1536 * 512, 512, (const bf16_t*)(q2.ws + WS_P) + 1536, NPO, 1536, MR, 512, 0, eq, 1, &tfq);
      EpiUKV ek{(bf16_t*)(q2.ws + WS_KV), (bf16_t*)(q2.ws + WS_VMT)};
      const TileFuse tfk{3, e};
      gemm_phase(lds, (const bf16_t*)(q2.ws + WS_WTUKV) + (size_t)e * 2048 * 256, 256, (const bf16_t*)(q2.ws + WS_P) + 2048, NPO, 2048, MR, 256, 0, ek, 1, &tfk);
    }
    grid_barrier((unsigned*)(PP.ws + WS_BAR), (volatile unsigned*)(lds + LDS_RED + 128), TIDX());
    for (int rep = 0; rep < (PROBE == 1 ? 2 : 1); ++rep)
    for (int it = vblock(); it < 528; it += gridDim.x) {
      if (it < 256) attn_items_AC<true>(PP, lds, layer, it);
      else if (it < 512) attn_items_D(PP, lds, it - 256);
      else if (it < 520) attn_items_AC<true>(PP, lds, layer, 256 + (it - 512));
      else attn_items_D(PP, lds, 256 + (it - 520));
    }
    grid_barrier((unsigned*)(PP.ws + WS_BAR), (volatile unsigned*)(lds + LDS_RED + 128), TIDX());
  } else {
    {
      const c32* TWg = (const c32*)(PP.ws + WS_TW); c32* wt = (c32*)(lds + LDS_WT); const int t_ = TIDX();
      for (int j = t_; j < 1024; j += NTH) wt[j] = TWg[j];
      if (t_ < 64) wt[1024 + t_] = TWg[t_ << 4];
      if (t_ < 4) wt[1088 + t_] = TWg[t_ << 8];
      __syncthreads();
    }
    for (int rep = 0; rep < (PROBE == 3 ? 2 : 1); ++rep)
    for (int it = vblock(); it < 256 + 264 + 512; it += gridDim.x) {
      if (it < 256) hyena_item(PP, lds, e, it);
      else if (it < 256 + 264) attn_items_AC<false>(PP, lds, layer, it - 256);
      else hyena_ctx_item(PP, lds, e, it - 520);
    }
    grid_barrier((unsigned*)(PP.ws + WS_BAR), (volatile unsigned*)(lds + LDS_RED + 128), TIDX());
  }
  {
    const Params& q = PP; EpiOut eo{(float*)(q.ws + WS_H), q.out, (const float*)(q.ws + WS_MODS), layer};
    gemm_phase(lds, (const bf16_t*)(PP.ws + WS_WTOUT) + (size_t)layer * D * D, D, (const bf16_t*)(PP.ws + WS_O), D, D, MR, D, 1, eo);
    if (layer < 3) {
      EpiOutPart ea{(float*)(q.ws + WS_PART)};
      gemm_phase(lds, (const bf16_t*)(PP.ws + WS_WTOUT) + (size_t)layer * D * D, D, (const bf16_t*)(PP.ws + WS_O), D, D, 256, D, 0, ea, 8);
    }
  }
}
__global__ void __launch_bounds__(NTH) fwd_megakernel(Params p_unused) {
  extern __shared__ __attribute__((aligned(16))) unsigned char lds[];
  cg::grid_group grid = cg::this_grid();
  {
    volatile unsigned* st = (volatile unsigned*)(lds + LDS_RED + 128);
    unsigned* bar0 = (unsigned*)(PP.ws + WS_BAR);
    if (TIDX() == 0) { st[0] = 0u; st[1] = 0u; (void)xb_add(&bar0[XB_XCNT(xb_xcc_id())], 1u); }
    __syncthreads();
  }
  phase_prep(PP, lds);
  grid.sync();
  for (int l2 = 0; l2 < 2; ++l2) {
    layer_body<false>(lds, 2 * l2);
    grid_barrier((unsigned*)(PP.ws + WS_BAR), (volatile unsigned*)(lds + LDS_RED + 128), TIDX());
    layer_body<true>(lds, 2 * l2 + 1);
    if (l2 == 0) grid_barrier((unsigned*)(PP.ws + WS_BAR), (volatile unsigned*)(lds + LDS_RED + 128), TIDX());
  }
}

extern "C" void kernel_launch(void* const* d_in, const int* in_sizes, int n_in, void* d_out, int out_size, void* d_ws, size_t ws_size, hipStream_t stream) {
  static int grid_blocks = 0;
  if (grid_blocks == 0) {
    if (n_in != 31 || ws_size < WS_END) { fprintf(stderr, "kernel_launch: bad inputs n_in=%d ws=%zu need=%zu\n", n_in, ws_size, (size_t)WS_END); grid_blocks = -1; return; }
    int dev = 0, cus = 0, per_cu = 0;
    (void)hipGetDevice(&dev);
    (void)hipDeviceGetAttribute(&cus, hipDeviceAttributeMultiprocessorCount, dev);
    if (hipFuncSetAttribute((const void*)fwd_megakernel, hipFuncAttributeMaxDynamicSharedMemorySize, LDS_BYTES) != hipSuccess) { fprintf(stderr, "kernel_launch: hipFuncSetAttribute failed\n"); grid_blocks = -1; return; }
    if (hipOccupancyMaxActiveBlocksPerMultiprocessor(&per_cu, (const void*)fwd_megakernel, NTH, LDS_BYTES) != hipSuccess || per_cu < 1) { fprintf(stderr, "kernel_launch: occupancy query failed (%d)\n", per_cu); per_cu = 1; }
    (void)hipGetLastError();
    grid_blocks = cus * per_cu;
  }
  if (grid_blocks < 0) return;
  (void)hipMemsetAsync((unsigned char*)d_ws + WS_MODS, 0, WS_TW - WS_MODS, stream);
  Params p{};
  for (int i = 0; i < 31; ++i) p.in[i] = (const float*)d_in[i];
  p.out = (float*)d_out; p.ws = (unsigned char*)d_ws;
  void* args[] = {&p};
  hipError_t er = hipLaunchCooperativeKernel((const void*)fwd_megakernel, dim3(grid_blocks), dim3(NTH), args, LDS_BYTES, stream);
  if (er != hipSuccess) fprintf(stderr, "cooperative launch failed: %s (grid %d)\n", hipGetErrorString(er), grid_blocks);
}
```
